# Optimizing an MI355X kernel written in HIP

```python
import math
import jax, jax.numpy as jnp
from jax import lax
import numpy as np

D_MODEL = 2048
BATCH = 2
SEQ = 4096
DEPTH = 1

EPS = 1e-6
BLOCK_Q = 128
CONV_WIDTH = D_MODEL // 2
CONV_GROUPS = 8
CONV_TAPS = 3
FOX_HEAD_DIM = 128
FOX_HEADS = (D_MODEL // 2) // FOX_HEAD_DIM
FOX_WIDTH = FOX_HEADS * FOX_HEAD_DIM
MEM_TOKENS = 256
MEM_HEADS = 4
MEM_HEAD_DIM = (D_MODEL // 2) // MEM_HEADS
MEM_WIDTH = MEM_HEADS * MEM_HEAD_DIM
N_BRANCHES = 3
D_FF = 4 * D_MODEL
IN_COLS = 3 * CONV_WIDTH + 3 * FOX_WIDTH + FOX_HEADS + MEM_WIDTH + N_BRANCHES * D_MODEL

kernel_name = "hybrid_gated_conv_fox_memxattn_block"


def _rms(x, g):
    xf = x.astype(jnp.float32)
    y = xf * lax.rsqrt(jnp.mean(xf * xf, axis=-1, keepdims=True) + EPS)
    return (y * g.astype(jnp.float32)).astype(x.dtype)


def _causal_dwconv(u, w):
    s = u.shape[1]
    up = jnp.pad(u, ((0, 0), (CONV_TAPS - 1, 0), (0, 0)))
    y = w[0] * up[:, 0:s]
    for i in range(1, CONV_TAPS):
        y = y + w[i] * up[:, i:i + s]
    return y


def _forgetting_attention(q, k, v, log_f):
    b, s, h, d = q.shape
    nb = s // BLOCK_Q
    c = jnp.cumsum(log_f, axis=1).transpose(0, 2, 1)
    qh = q.transpose(0, 2, 1, 3)
    kh = k.transpose(0, 2, 1, 3)
    vh = v.transpose(0, 2, 1, 3)
    q_blocks = qh.reshape(b, h, nb, BLOCK_Q, d).transpose(2, 0, 1, 3, 4)
    c_blocks = c.reshape(b, h, nb, BLOCK_Q).transpose(2, 0, 1, 3)
    pos_blocks = jnp.arange(s).reshape(nb, BLOCK_Q)
    kpos = jnp.arange(s)
    scale = 1.0 / math.sqrt(d)

    def one_block(args):
        qb, cb, pb = args
        logits = jnp.einsum('bhqd,bhkd->bhqk', qb, kh,
                            preferred_element_type=jnp.float32) * scale
        logits = logits + (cb[..., None] - c[:, :, None, :])
        logits = jnp.where(pb[:, None] >= kpos[None, :], logits, -jnp.inf)
        p = jax.nn.softmax(logits, axis=-1)
        return jnp.einsum('bhqk,bhkd->bhqd', p.astype(vh.dtype), vh)

    out = lax.map(one_block, (q_blocks, c_blocks, pos_blocks))
    return out.transpose(1, 0, 3, 2, 4).reshape(b, s, h * d)


def _memory_attention(qm, mem, mem_norm_g, w_mem_kv, mem_q_g, mem_k_g):
    b, s, _, _ = qm.shape
    m = mem.shape[1]
    kv = _rms(mem, mem_norm_g) @ w_mem_kv
    km = kv[..., :MEM_WIDTH].reshape(b, m, MEM_HEADS, MEM_HEAD_DIM)
    vm = kv[..., MEM_WIDTH:].reshape(b, m, MEM_HEADS, MEM_HEAD_DIM)
    qm = _rms(qm, mem_q_g)
    km = _rms(km, mem_k_g)
    logits = jnp.einsum('bshd,bmhd->bhsm', qm, km,
                        preferred_element_type=jnp.float32) / math.sqrt(MEM_HEAD_DIM)
    p = jax.nn.softmax(logits, axis=-1)
    out = jnp.einsum('bhsm,bmhd->bshd', p.astype(vm.dtype), vm)
    return out.reshape(b, s, MEM_WIDTH)


def setup_inputs(seed: int = 0) -> dict:
    key = jax.random.key(seed)
    ks = jax.random.split(key, 20)
    f32 = jnp.float32

    def nrm(k, shape, fan_in):
        return jax.random.normal(k, shape, f32) * (fan_in ** -0.5)

    def gain(k, n):
        return 1.0 + 0.02 * jax.random.normal(k, (n,), f32)

    return {
        "x": jax.random.normal(ks[0], (BATCH, SEQ, D_MODEL), f32),
        "mem": jax.random.normal(ks[1], (BATCH, MEM_TOKENS, D_MODEL), f32),
        "norm1_g": gain(ks[2], D_MODEL),
        "w_in": nrm(ks[3], (D_MODEL, IN_COLS), D_MODEL),
        "b_f": jax.random.uniform(ks[4], (FOX_HEADS,), f32, minval=1.0, maxval=4.0),
        "conv_w": nrm(ks[5], (CONV_TAPS, CONV_WIDTH), CONV_TAPS),
        "fox_q_g": gain(ks[6], FOX_HEAD_DIM),
        "fox_k_g": gain(ks[7], FOX_HEAD_DIM),
        "mem_norm_g": gain(ks[8], D_MODEL),
        "w_mem_kv": nrm(ks[9], (D_MODEL, 2 * MEM_WIDTH), D_MODEL),
        "mem_q_g": gain(ks[10], MEM_HEAD_DIM),
        "mem_k_g": gain(ks[11], MEM_HEAD_DIM),
        "w_conv_out": nrm(ks[12], (CONV_WIDTH, D_MODEL), CONV_WIDTH),
        "w_fox_out": nrm(ks[13], (FOX_WIDTH, D_MODEL), FOX_WIDTH),
        "w_mem_out": nrm(ks[14], (MEM_WIDTH, D_MODEL), MEM_WIDTH),
        "w_out": nrm(ks[15], (D_MODEL, D_MODEL), D_MODEL),
        "norm2_g": gain(ks[16], D_MODEL),
        "w_up": nrm(ks[17], (D_MODEL, D_FF), D_MODEL),
        "w_down": nrm(ks[18], (D_FF, D_MODEL), D_FF),
    }


def reference(x, mem, norm1_g, w_in, b_f, conv_w, fox_q_g, fox_k_g, mem_norm_g,
              w_mem_kv, mem_q_g, mem_k_g, w_conv_out, w_fox_out, w_mem_out,
              w_out, norm2_g, w_up, w_down):
    b, s, _ = x.shape
    for _layer in range(DEPTH):
        h = _rms(x, norm1_g)
        proj = h @ w_in
        o = 0
        conv_bg = proj[..., o:o + CONV_WIDTH]; o += CONV_WIDTH
        conv_cg = proj[..., o:o + CONV_WIDTH]; o += CONV_WIDTH
        conv_v = proj[..., o:o + CONV_WIDTH]; o += CONV_WIDTH
        fq = proj[..., o:o + FOX_WIDTH]; o += FOX_WIDTH
        fk = proj[..., o:o + FOX_WIDTH]; o += FOX_WIDTH
        fv = proj[..., o:o + FOX_WIDTH]; o += FOX_WIDTH
        f_logit = proj[..., o:o + FOX_HEADS]; o += FOX_HEADS
        mq = proj[..., o:o + MEM_WIDTH]; o += MEM_WIDTH
        gate_logit = proj[..., o:o + N_BRANCHES * D_MODEL]

        y_conv = conv_bg * _causal_dwconv(conv_cg * conv_v, conv_w)
        o_conv = y_conv @ w_conv_out

        fq = _rms(fq.reshape(b, s, FOX_HEADS, FOX_HEAD_DIM), fox_q_g)
        fk = _rms(fk.reshape(b, s, FOX_HEADS, FOX_HEAD_DIM), fox_k_g)
        fv = fv.reshape(b, s, FOX_HEADS, FOX_HEAD_DIM)
        log_f = jax.nn.log_sigmoid(f_logit.astype(jnp.float32) + b_f.astype(jnp.float32))
        o_fox = _forgetting_attention(fq, fk, fv, log_f) @ w_fox_out

        mq = mq.reshape(b, s, MEM_HEADS, MEM_HEAD_DIM)
        o_mem = _memory_attention(mq, mem, mem_norm_g, w_mem_kv, mem_q_g, mem_k_g) @ w_mem_out

        g = jax.nn.sigmoid(gate_logit).reshape(b, s, N_BRANCHES, D_MODEL)
        merged = g[:, :, 0] * o_conv + g[:, :, 1] * o_fox + g[:, :, 2] * o_mem
        x = x + merged @ w_out

        h2 = _rms(x, norm2_g)
        x = x + jnp.square(jax.nn.relu(h2 @ w_up)) @ w_down
    return x
```

```cpp
#include <hip/hip_runtime.h>
#include <hip/hip_bf16.h>
#include <cstdio>
#include <cstdint>

typedef unsigned short bf16_t;
typedef short bf16x8 __attribute__((ext_vector_type(8)));
typedef float f32x4 __attribute__((ext_vector_type(4)));
typedef float f32x16 __attribute__((ext_vector_type(16)));
typedef unsigned u32x4 __attribute__((ext_vector_type(4)));
typedef unsigned u32x2 __attribute__((ext_vector_type(2)));

constexpr int BATCH = 2, SEQ = 4096, DM = 2048, M = BATCH * SEQ;
constexpr int CW = 1024, FH = 8, FD = 128, MT = 256, MH = 4, MD = 256, DFF = 8192;
constexpr int IN_COLS = 13320, OC_FL = 6144;
constexpr int NPACK = 13312;
constexpr int PJ = 7168;
constexpr int PC_BG = 0, PC_CG = 1024, PC_V = 2048, PC_FQ = 3072, PC_FK = 4096, PC_FV = 5120, PC_MQ = 6144;
constexpr int NG = 6144;
constexpr float EPS = 1e-6f;
constexpr float LOG2E = 1.4426950408889634f;
constexpr float C2F = 0.08838834764831845f * LOG2E;
constexpr float C2M = 0.0625f * LOG2E;

constexpr size_t MiB = 1u << 20;
constexpr size_t WS_CTL = 0;
constexpr size_t WS_WIN = 1 * MiB;
constexpr size_t WS_WC = 61 * MiB;
constexpr size_t WS_WOUT = 73 * MiB;
constexpr size_t WS_WUP = 81 * MiB;
constexpr size_t WS_WDN = 113 * MiB;
constexpr size_t WS_HB = 145 * MiB;
constexpr size_t WS_PROJ = 179 * MiB;
constexpr size_t WS_GATES = 291 * MiB;
constexpr size_t WS_KV = 387 * MiB;
constexpr size_t WS_VMT = 389 * MiB;
constexpr size_t WS_PM = 390 * MiB;
constexpr size_t WS_LF = 406 * MiB;
constexpr size_t WS_NCK = WS_LF + 256 * 1024;
constexpr size_t WS_SSP = 407 * MiB;
constexpr size_t WS_END = 408 * MiB;
constexpr size_t WS_MERGED = WS_WIN;
constexpr size_t WS_U = WS_PROJ;
constexpr size_t WS_X1B = WS_HB;

__device__ __forceinline__ float bf2f(bf16_t v) { return __uint_as_float(((unsigned)v) << 16); }
__device__ __forceinline__ bf16_t f2bf(float f) { unsigned u = __float_as_uint(f); return (bf16_t)((u + 0x7fffu + ((u >> 16) & 1u)) >> 16); }
__device__ __forceinline__ unsigned pk2(float lo, float hi) { return (unsigned)f2bf(lo) | ((unsigned)f2bf(hi) << 16); }
__device__ __forceinline__ float wave_sum(float v) {
#pragma unroll
    for (int o = 1; o < 64; o <<= 1) v += __shfl_xor(v, o);
    return v;
}
__device__ __forceinline__ float wave_max(float v) {
#pragma unroll
    for (int o = 1; o < 64; o <<= 1) v = fmaxf(v, __shfl_xor(v, o));
    return v;
}
__device__ __forceinline__ void unpack8(u32x4 w, float* v) {
    v[0] = __uint_as_float(w.x << 16); v[1] = __uint_as_float(w.x & 0xffff0000u);
    v[2] = __uint_as_float(w.y << 16); v[3] = __uint_as_float(w.y & 0xffff0000u);
    v[4] = __uint_as_float(w.z << 16); v[5] = __uint_as_float(w.z & 0xffff0000u);
    v[6] = __uint_as_float(w.w << 16); v[7] = __uint_as_float(w.w & 0xffff0000u);
}
__device__ __forceinline__ u32x4 pack8f(const float* v) { u32x4 w; w.x = pk2(v[0], v[1]); w.y = pk2(v[2], v[3]); w.z = pk2(v[4], v[5]); w.w = pk2(v[6], v[7]); return w; }

__device__ __forceinline__ void elem_scan(int bh, int tid, const float* __restrict__ lf, float* __restrict__ nck, __attribute__((address_space(3))) float* xs) {
    const int b = bh >> 3, h = bh & 7, lane = tid & 63, wave = tid >> 6;
    const float* src = lf + ((size_t)b * SEQ + 8 * tid) * 8 + h;
    float v[8];
#pragma unroll
    for (int e = 0; e < 8; ++e) v[e] = src[e * 8];
    float s = 0.f;
#pragma unroll
    for (int e = 0; e < 8; ++e) { s += v[e]; v[e] = s; }
    float incl = s;
#pragma unroll
    for (int o = 1; o < 64; o <<= 1) { const float n = __shfl_up(incl, o); if (lane >= o) incl += n; }
    if (lane == 63) xs[wave] = incl;
    __syncthreads();
    float off = incl - s;
    for (int w = 0; w < wave; ++w) off += xs[w];
    f32x4 o0, o1;
#pragma unroll
    for (int e = 0; e < 4; ++e) { o0[e] = -(off + v[e]) * LOG2E; o1[e] = -(off + v[4 + e]) * LOG2E; }
    float* dst = nck + (size_t)bh * SEQ + 8 * tid;
    *(f32x4*)dst = o0; *(f32x4*)(dst + 4) = o1;
}

namespace pg8 {
#define PG8_LAS __attribute__((address_space(3)))
constexpr int BM = 256, BK = 64, HALF = 128, HTB = HALF * BK * 2, STAGE_BYTES = 8 * HTB, NXCD = 8, WGM = 4;
__host__ __device__ __forceinline__ int lds_byte(int r, int c) { const int st = (r >> 4) * 2 + (c >> 5), rr = r & 15, cc = c & 31, ob = rr * 64 + cc * 2; return st * 1024 + (ob ^ (((ob >> 9) & 1) << 5)); }
__host__ __device__ __forceinline__ void stage_rc(int b, int& R, int& C) { const int st = b / 1024, sb = b % 1024, swz = sb ^ (((sb >> 9) & 1) << 5); R = (st >> 1) * 16 + swz / 64; C = (st & 1) * 32 + (swz % 64) / 2; }
__host__ __device__ __forceinline__ int perm32(int rho) { const int n = rho >> 4, i = rho & 15; return 8 * (i >> 2) + 4 * n + (i & 3); }
struct Unit { unsigned A, B; int pm, pn, seg; };
typedef __amdgpu_buffer_rsrc_t Rsrc;
__device__ __forceinline__ void tile_of(int L, int nM, int nN, int& pm, int& pn) {
    const int nwg = nM * nN; int wgid = L;
    { const int q = nwg / NXCD, r = nwg % NXCD, xcd = wgid % NXCD, off = wgid / NXCD; wgid = (xcd < r ? xcd * (q + 1) : r * (q + 1) + (xcd - r) * q) + off; }
    const int nig = WGM * nN, gid = wgid / nig, fm = gid * WGM, gsz = (nM - fm) < WGM ? (nM - fm) : WGM;
    pm = fm + ((wgid % nig) % gsz); pn = (wgid % nig) / gsz;
}
__device__ __forceinline__ unsigned cvt_pk_bf16(float lo, float hi) { unsigned r; asm volatile("v_cvt_pk_bf16_f32 %0, %1, %2" : "=v"(r) : "v"(lo), "v"(hi)); return r; }
template <class Epi, class Sched, bool ALIGN_EPI = true, bool SP2 = true, bool PEEL = false>
__device__ __forceinline__ void gemm_phase(unsigned char* wsb, PG8_LAS unsigned char* lds, const int lda, const int ldb, const int K, const Sched& S, const Epi& E) {
    int tid_ = threadIdx.x; asm volatile("" : "+v"(tid_));
    asm volatile("" : "+s"(wsb));
    const Rsrc rs = __builtin_amdgcn_make_buffer_rsrc((void*)wsb, 0, -1, 0x00020000);
    const int tid = tid_, wid = __builtin_amdgcn_readfirstlane(tid >> 6), lane = tid & 63, wr = wid >> 2, wc = wid & 3, fr = lane & 15, fq = lane >> 4;
    const int nt = K / BK;
    unsigned voffA[2], voffB[2];
#pragma unroll
    for (int i = 0; i < 2; ++i) { int R, C; stage_rc(tid * 16 + i * 8192, R, C); const int Rb = (R & ~31) + perm32(R & 31);
        voffA[i] = (unsigned)(R * lda + C) * 2u; voffB[i] = (unsigned)(Rb * ldb + C) * 2u; }
    const unsigned kstep = (unsigned)(BK * 2);
    const unsigned hstepA = (unsigned)HALF * lda * 2, hstepB = (unsigned)HALF * ldb * 2;
    const unsigned ldsw = (unsigned)wid * 1024u;
    const int aoff = lds_byte(wr * 64 + fr, fq * 8), boff = lds_byte(wc * 32 + fr, fq * 8);
#define PG8_SA(b, h) (((b) * 2 + (h)) * HTB)
#define PG8_SB(b, h) ((4 + (b) * 2 + (h)) * HTB)
#define PG8_STAGE(bufoff, soff, voff) do { _Pragma("unroll") for (int _i = 0; _i < 2; ++_i) \
        __builtin_amdgcn_raw_ptr_buffer_load_lds(rs, (PG8_LAS void*)(lds + (bufoff) + ldsw + _i * 8192), 16, (int)(voff)[_i], (int)(soff), 0, 0); } while (0)
#define PG8_LDA(dst, b, h) do { _Pragma("unroll") for (int m = 0; m < 4; ++m) _Pragma("unroll") for (int k = 0; k < 2; ++k) dst[m][k] = *(const PG8_LAS bf16x8*)(lds + PG8_SA(b, h) + aoff + m * 2048 + k * 1024); } while (0)
#define PG8_LDB(dst, b, h) do { _Pragma("unroll") for (int n = 0; n < 2; ++n) _Pragma("unroll") for (int k = 0; k < 2; ++k) dst[n][k] = *(const PG8_LAS bf16x8*)(lds + PG8_SB(b, h) + boff + n * 2048 + k * 1024); } while (0)
#define PG8_MMA(ai, bj, At, Bt) do { __builtin_amdgcn_s_setprio(1); _Pragma("unroll") for (int m = 0; m < 4; ++m) _Pragma("unroll") for (int n = 0; n < 2; ++n) _Pragma("unroll") for (int k = 0; k < 2; ++k) \
        acc[ai][bj][m][n] = __builtin_amdgcn_mfma_f32_16x16x32_bf16(Bt[n][k], At[m][k], acc[ai][bj][m][n], 0, 0, 0); __builtin_amdgcn_s_setprio(0); } while (0)
#define PG8_WAIT_V(n) asm volatile("s_waitcnt vmcnt(" #n ")" ::: "memory")
#define PG8_WAIT_L(n) asm volatile("s_waitcnt lgkmcnt(" #n ")" ::: "memory")
#define PG8_BAR __builtin_amdgcn_s_barrier()
#define PG8_SCHED __builtin_amdgcn_sched_barrier(0)
    Unit cur, nxt; int ui = 0;
    if (!S.next(0, cur)) return;
    f32x4 acc[2][2][4][2];
#pragma unroll
    for (int a = 0; a < 2; ++a)
#pragma unroll
        for (int b = 0; b < 2; ++b)
#pragma unroll
            for (int m = 0; m < 4; ++m)
#pragma unroll
                for (int n = 0; n < 2; ++n) acc[a][b][m][n] = (f32x4){0.f, 0.f, 0.f, 0.f};
    bf16x8 At[4][2], B0[2][2], B1[2][2];
    unsigned cA = cur.A, cB = cur.B;
    if constexpr (SP2) {
        PG8_STAGE(PG8_SB(0, 0), cB, voffB); PG8_STAGE(PG8_SB(0, 1), cB + hstepB, voffB); PG8_STAGE(PG8_SA(0, 0), cA, voffA); PG8_STAGE(PG8_SA(0, 1), cA + hstepA, voffA);
        PG8_STAGE(PG8_SB(1, 0), cB + kstep, voffB); PG8_STAGE(PG8_SA(1, 0), cA + kstep, voffA); PG8_STAGE(PG8_SB(1, 1), cB + hstepB + kstep, voffB);
        if (wr == 1) PG8_BAR;
        PG8_WAIT_V(8); PG8_BAR;
        PG8_WAIT_V(6); PG8_BAR;
    } else {
        PG8_STAGE(PG8_SB(0, 0), cB, voffB); PG8_STAGE(PG8_SA(0, 0), cA, voffA); PG8_STAGE(PG8_SB(0, 1), cB + hstepB, voffB); PG8_STAGE(PG8_SA(0, 1), cA + hstepA, voffA);
        if (wr == 1) PG8_BAR;
        PG8_WAIT_V(4); PG8_BAR;
        PG8_STAGE(PG8_SB(1, 0), cB + kstep, voffB); PG8_STAGE(PG8_SA(1, 0), cA + kstep, voffA); PG8_STAGE(PG8_SB(1, 1), cB + hstepB + kstep, voffB);
        PG8_WAIT_V(6); PG8_BAR;
    }
    for (;;) {
        const bool has_next = S.next(ui + 1, nxt);
        const unsigned nA = has_next ? nxt.A : cA, nB = has_next ? nxt.B : cB;
#define PG8_TRIP(t, W) do { \
            const bool last = ((t) == nt - 2); \
            const unsigned a1 = cA + (unsigned)((t) + 1) * kstep; \
            const unsigned a2 = last ? nA : cA + (unsigned)((t) + 2) * kstep, b2 = last ? nB : cB + (unsigned)((t) + 2) * kstep; \
            const unsigned a3 = a2 + kstep, b3 = b2 + kstep; \
            PG8_LDB(B0, 0, 0); PG8_LDB(B1, 0, 1); PG8_SCHED; PG8_LDA(At, 0, 0); PG8_STAGE(PG8_SA(1, 1), a1 + hstepA, voffA); \
            PG8_WAIT_V(W); PG8_WAIT_L(0); PG8_BAR; PG8_MMA(0, 0, At, B0); PG8_MMA(0, 1, At, B1); PG8_BAR; PG8_SCHED; \
            PG8_LDA(At, 0, 1); PG8_STAGE(PG8_SB(0, 0), b2, voffB); PG8_STAGE(PG8_SB(0, 1), b2 + hstepB, voffB); PG8_STAGE(PG8_SA(0, 0), a2, voffA); \
            PG8_WAIT_V(W); PG8_WAIT_L(0); PG8_BAR; PG8_MMA(1, 0, At, B0); PG8_MMA(1, 1, At, B1); PG8_BAR; PG8_SCHED; \
            PG8_LDB(B0, 1, 0); PG8_LDB(B1, 1, 1); PG8_SCHED; PG8_LDA(At, 1, 0); PG8_STAGE(PG8_SA(0, 1), a2 + hstepA, voffA); \
            PG8_WAIT_V(8); PG8_WAIT_L(0); PG8_BAR; PG8_MMA(0, 0, At, B0); PG8_MMA(0, 1, At, B1); PG8_BAR; PG8_SCHED; \
            PG8_LDA(At, 1, 1); PG8_STAGE(PG8_SB(1, 0), b3, voffB); PG8_STAGE(PG8_SB(1, 1), b3 + hstepB, voffB); PG8_STAGE(PG8_SA(1, 0), a3, voffA); \
            PG8_WAIT_V(8); PG8_WAIT_L(0); PG8_BAR; PG8_MMA(1, 0, At, B0); PG8_MMA(1, 1, At, B1); PG8_BAR; PG8_SCHED; } while (0)
        static_assert(SP2, "this build keeps only the two-MFMA-blocks-per-barrier-pair schedule");
        int t0 = 0;
        if constexpr (PEEL) { if (ui > 0) { PG8_TRIP(0, 24); t0 = 2; } }
        for (int t = t0; t < nt; t += 2) PG8_TRIP(t, 8);
#undef PG8_TRIP
        if constexpr (ALIGN_EPI) { if (wr == 0) PG8_BAR; }
        E(acc, cur, wr, wc, fr, fq, lds);
        if (!has_next) break;
#pragma unroll
        for (int a = 0; a < 2; ++a)
#pragma unroll
            for (int b = 0; b < 2; ++b)
#pragma unroll
                for (int m = 0; m < 4; ++m)
#pragma unroll
                    for (int n = 0; n < 2; ++n) acc[a][b][m][n] = (f32x4){0.f, 0.f, 0.f, 0.f};
        cur = nxt; cA = nA; cB = nB; ++ui;
        if constexpr (ALIGN_EPI) { if (wr == 1) PG8_BAR; }
    }
    PG8_WAIT_V(0);
    if constexpr (!ALIGN_EPI) { if (wr == 0) PG8_BAR; }
    PG8_BAR;
#undef PG8_SA
#undef PG8_SB
#undef PG8_STAGE
#undef PG8_LDA
#undef PG8_LDB
#undef PG8_MMA
#undef PG8_WAIT_V
#undef PG8_WAIT_L
#undef PG8_BAR
#undef PG8_SCHED
}
typedef f32x4 Acc[2][2][4][2];
constexpr int XCH_OFF = 131072 + 1024;

struct EpiP1 { bf16_t* proj; bf16_t* gates; bf16_t* kv; bf16_t* vmT; const float* fqg; const float* fkg; const float* mqg; const float* mkg; const float* conv_w;
    __device__ __forceinline__ void operator()(Acc& acc, const Unit& u, int wr, int wc, int fr, int fq, PG8_LAS unsigned char* lds) const {
        asm volatile("" : "+v"(fr), "+v"(fq));
        bf16_t* base; int ldc; int kind = 0; int colt = u.pn * BM;
        if (u.seg == 1) { base = kv; ldc = 2048; kind = 3; }
        else if (u.seg == 2) { base = vmT + (size_t)u.pn * (MD * MT); ldc = MT; colt = 0; }
        else if (u.pn < PJ / BM) { base = proj; ldc = PJ; kind = u.seg >= 4 ? u.seg : ((u.pn >= PC_FQ / BM && u.pn < PC_FV / BM) ? 2 : (u.pn >= PC_MQ / BM ? 3 : 0)); }
        else { base = gates; ldc = NG; colt -= PJ; kind = 1; }
        const int row0 = u.pm + wr * 64 + fr, col0 = colt + wc * 32 + 8 * fq;
        if (kind == 4) {
#pragma unroll
            for (int ai = 0; ai < 2; ++ai) { u32x4 Cq[4][2];
#pragma unroll
                for (int m = 0; m < 4; ++m)
#pragma unroll
                    for (int bj = 0; bj < 2; ++bj) Cq[m][bj] = *(const u32x4*)((const char*)base + (unsigned)((row0 + ai * HALF + m * 16) * PJ + col0 + bj * HALF - (PC_V - PC_CG)) * 2u);
#pragma unroll
                for (int m = 0; m < 4; ++m)
#pragma unroll
                    for (int bj = 0; bj < 2; ++bj) { float g[8]; unpack8(Cq[m][bj], g);
                        f32x4 v0 = acc[ai][bj][m][0], v1 = acc[ai][bj][m][1];
#pragma unroll
                        for (int e = 0; e < 4; ++e) { v0[e] *= g[e]; v1[e] *= g[4 + e]; }
                        u32x4 w; w.x = cvt_pk_bf16(v0[0], v0[1]); w.y = cvt_pk_bf16(v0[2], v0[3]); w.z = cvt_pk_bf16(v1[0], v1[1]); w.w = cvt_pk_bf16(v1[2], v1[3]);
                        *(u32x4*)((char*)base + (unsigned)((row0 + ai * HALF + m * 16) * PJ + col0 + bj * HALF) * 2u) = w; }
                asm volatile("" ::: "memory"); }
            return;
        }
        if (kind == 5) {
            const bool first = (u.pm & (SEQ - 1)) == 0;
#pragma unroll
            for (int bj = 0; bj < 2; ++bj) { const int ch = col0 + bj * HALF;
                const f32x4 k0a = *(const f32x4*)(conv_w + ch), k0b = *(const f32x4*)(conv_w + ch + 4), k1a = *(const f32x4*)(conv_w + CW + ch), k1b = *(const f32x4*)(conv_w + CW + ch + 4),
                            k2a = *(const f32x4*)(conv_w + 2 * CW + ch), k2b = *(const f32x4*)(conv_w + 2 * CW + ch + 4);
#pragma unroll
                for (int ai = 0; ai < 2; ++ai) { u32x4 Uq[4][3];
#pragma unroll
                    for (int m = 0; m < 4; ++m) { const int row = row0 + ai * HALF + m * 16; const unsigned o0 = (unsigned)(row * PJ + PC_V + ch) * 2u;
                        Uq[m][0] = *(const u32x4*)((const char*)base + o0); Uq[m][1] = *(const u32x4*)((const char*)base + (row >= 1 ? o0 - 2u * PJ : o0)); Uq[m][2] = *(const u32x4*)((const char*)base + (row >= 2 ? o0 - 4u * PJ : o0)); }
#pragma unroll
                    for (int m = 0; m < 4; ++m) { const int row = row0 + ai * HALF + m * 16, t = row & (SEQ - 1), lr = ai * HALF + wr * 64 + m * 16 + fr;
                        const u32x4 Z = {0u, 0u, 0u, 0u};
                        float a0[8], a1[8], a2[8]; unpack8(Uq[m][0], a0); unpack8(t >= 1 ? Uq[m][1] : Z, a1); unpack8(t >= 2 ? Uq[m][2] : Z, a2);
                        f32x4 v0 = acc[ai][bj][m][0], v1 = acc[ai][bj][m][1];
#pragma unroll
                        for (int e = 0; e < 4; ++e) { v0[e] *= k2a[e] * a0[e] + k1a[e] * a1[e] + k0a[e] * a2[e]; v1[e] *= k2b[e] * a0[4 + e] + k1b[e] * a1[4 + e] + k0b[e] * a2[4 + e]; }
                        u32x4 w; w.x = cvt_pk_bf16(v0[0], v0[1]); w.y = cvt_pk_bf16(v0[2], v0[3]); w.z = cvt_pk_bf16(v1[0], v1[1]); w.w = cvt_pk_bf16(v1[2], v1[3]);
                        if (first || lr >= 2) *(u32x4*)((char*)base + (unsigned)(row * PJ + ch) * 2u) = w; }
                    asm volatile("" ::: "memory"); } }
            return;
        }
        if (kind >= 2) {
            PG8_LAS float* X = (PG8_LAS float*)(lds + XCH_OFF);
#pragma unroll
            for (int ai = 0; ai < 2; ++ai)
#pragma unroll
                for (int m = 0; m < 4; ++m)
#pragma unroll
                    for (int bj = 0; bj < 2; ++bj) { const f32x4 v0 = acc[ai][bj][m][0], v1 = acc[ai][bj][m][1];
                        float s = (v0[0] * v0[0] + v0[1] * v0[1]) + (v0[2] * v0[2] + v0[3] * v0[3]) + (v1[0] * v1[0] + v1[1] * v1[1]) + (v1[2] * v1[2] + v1[3] * v1[3]);
                        s += __shfl_xor(s, 16); s += __shfl_xor(s, 32);
                        if (fq == 0) X[((ai * HALF + wr * 64 + m * 16 + fr) * 2 + bj) * 4 + wc] = s; }
            asm volatile("s_waitcnt lgkmcnt(0)" ::: "memory"); __builtin_amdgcn_s_barrier(); asm volatile("" ::: "memory");
            const bool isq = u.pn < PC_FK / BM;
            const float inv = kind == 3 ? (1.f / MD) : (1.f / FD);
            f32x4 g[2][2];
            if (kind == 3) { const float* gp = u.seg == 1 ? mkg : mqg; const float sc = u.seg == 1 ? 1.f : C2M;
#pragma unroll
                for (int bj = 0; bj < 2; ++bj) { const int gi = bj * HALF + wc * 32 + 8 * fq; g[bj][0] = *(const f32x4*)(gp + gi) * sc; g[bj][1] = *(const f32x4*)(gp + gi + 4) * sc; }
            } else if (isq) {
                const int gi = wc * 32 + 8 * fq; g[0][0] = *(const f32x4*)(fqg + gi) * C2F; g[0][1] = *(const f32x4*)(fqg + gi + 4) * C2F; g[1][0] = g[0][0]; g[1][1] = g[0][1];
            } else {
                const int gi = wc * 32 + 8 * fq; g[0][0] = *(const f32x4*)(fkg + gi); g[0][1] = *(const f32x4*)(fkg + gi + 4); g[1][0] = g[0][0]; g[1][1] = g[0][1];
            }
#pragma unroll
            for (int ai = 0; ai < 2; ++ai)
#pragma unroll
                for (int m = 0; m < 4; ++m) { const int rl = ai * HALF + wr * 64 + m * 16 + fr;
                    const f32x4 t0 = *(PG8_LAS const f32x4*)(X + rl * 8), t1 = *(PG8_LAS const f32x4*)(X + rl * 8 + 4);
                    float s0 = (t0[0] + t0[1]) + (t0[2] + t0[3]), s1 = (t1[0] + t1[1]) + (t1[2] + t1[3]);
                    if (kind == 3) { s0 += s1; s1 = s0; }
                    const float r0 = rsqrtf(s0 * inv + EPS), r1 = rsqrtf(s1 * inv + EPS);
                    bf16_t* rowp = base + (size_t)(row0 + ai * HALF + m * 16) * ldc + col0;
#pragma unroll
                    for (int bj = 0; bj < 2; ++bj) { const float r = bj ? r1 : r0; const f32x4 v0 = acc[ai][bj][m][0] * g[bj][0] * r, v1 = acc[ai][bj][m][1] * g[bj][1] * r;
                        u32x4 w; w.x = cvt_pk_bf16(v0[0], v0[1]); w.y = cvt_pk_bf16(v0[2], v0[3]); w.z = cvt_pk_bf16(v1[0], v1[1]); w.w = cvt_pk_bf16(v1[2], v1[3]);
                        *(u32x4*)(rowp + bj * HALF) = w; } }
            return;
        }
        const bool sig = kind == 1;
#pragma unroll
        for (int ai = 0; ai < 2; ++ai)
#pragma unroll
            for (int m = 0; m < 4; ++m) { bf16_t* rowp = base + (size_t)(row0 + ai * HALF + m * 16) * ldc + col0;
#pragma unroll
                for (int bj = 0; bj < 2; ++bj) { f32x4 v0 = acc[ai][bj][m][0], v1 = acc[ai][bj][m][1];
                    if (sig) {
#pragma unroll
                        for (int e = 0; e < 4; ++e) { v0[e] = __builtin_amdgcn_rcpf(1.f + __builtin_amdgcn_exp2f(-LOG2E * v0[e])); v1[e] = __builtin_amdgcn_rcpf(1.f + __builtin_amdgcn_exp2f(-LOG2E * v1[e])); } }
                    u32x4 w; w.x = cvt_pk_bf16(v0[0], v0[1]); w.y = cvt_pk_bf16(v0[2], v0[3]); w.z = cvt_pk_bf16(v1[0], v1[1]); w.w = cvt_pk_bf16(v1[2], v1[3]);
                    *(u32x4*)(rowp + bj * HALF) = w; } }
    } };
constexpr int P1_NTRI = BATCH * 17 * 4, P1_NPOOL = (M / BM) * ((NPACK - 3 * CW) / BM) + 16, P1_NUNITS = 3 * P1_NTRI + P1_NPOOL;
struct SchedP1 { unsigned hb, W; int G, c;
    __device__ __forceinline__ bool next(int i, Unit& u) const {
        constexpr int nM = M / BM, nN = (NPACK - 3 * CW) / BM, NMAIN = nM * nN;
        int p;
        if (i < 3) {
            if (c < P1_NTRI) { const int j = c & 3, q = c >> 2, b = q / 17, ti = q - 17 * b;
                u.pm = b * SEQ + (ti < 16 ? 254 * ti : SEQ - BM); u.pn = (i == 0 ? 4 : (i == 1 ? 8 : 0)) + j; u.seg = i == 0 ? 0 : 3 + i;
                u.A = hb + (unsigned)u.pm * DM * 2; u.B = W + (unsigned)u.pn * BM * DM * 2; return true; }
            p = i * (G - P1_NTRI) + (c - P1_NTRI);
        } else p = 3 * (G - P1_NTRI) + (i - 3) * G + c;
        if (p >= 16 + NMAIN) return false;
        if (p >= 16) { int pm, pn; tile_of(p - 16, nM, nN, pm, pn); u.pm = pm * BM; u.pn = pn + 3 * CW / BM; u.seg = 0; u.A = hb + (unsigned)u.pm * DM * 2; u.B = W + (unsigned)u.pn * BM * DM * 2; return true; }
        const int r = p;
        const int b = r >> 3, hm = r & 3;
        if ((r & 4) == 0) { u.seg = 1; u.pm = b * MT; u.pn = hm; u.A = hb + (unsigned)(M + b * MT) * DM * 2; u.B = W + (unsigned)(NPACK + hm * MD) * DM * 2; }
        else { u.seg = 2; u.pm = 0; u.pn = b * MH + hm; u.A = W + (unsigned)(NPACK + MH * MD + hm * MD) * DM * 2; u.B = hb + (unsigned)(M + b * MT) * DM * 2; }
        return true; } };

struct EpiP3 { const bf16_t* gates; bf16_t* tmp; bf16_t* merged;
    __device__ __forceinline__ void operator()(Acc& acc, const Unit& u, int wr, int wc, int fr, int fq, PG8_LAS unsigned char*) const {
        asm volatile("" : "+v"(fr), "+v"(fq));
        const int row0 = u.pm * BM + wr * 64 + fr, col0 = u.pn * BM + wc * 32 + 8 * fq;
#pragma unroll
        for (int ai = 0; ai < 2; ++ai) { u32x4 Gq[4][2], Tq[4][2];
#pragma unroll
            for (int m = 0; m < 4; ++m)
#pragma unroll
                for (int bj = 0; bj < 2; ++bj) { const size_t row = (size_t)(row0 + ai * HALF + m * 16); const int col = col0 + bj * HALF;
                    Gq[m][bj] = *(const u32x4*)(gates + row * NG + u.seg * DM + col); if (u.seg > 0) Tq[m][bj] = *(const u32x4*)(tmp + row * DM + col); }
#pragma unroll
            for (int m = 0; m < 4; ++m)
#pragma unroll
                for (int bj = 0; bj < 2; ++bj) { const size_t row = (size_t)(row0 + ai * HALF + m * 16); const int col = col0 + bj * HALF;
                    float g[8]; unpack8(Gq[m][bj], g);
                    f32x4 v0 = acc[ai][bj][m][0], v1 = acc[ai][bj][m][1];
#pragma unroll
                    for (int e = 0; e < 4; ++e) { v0[e] *= g[e]; v1[e] *= g[4 + e]; }
                    if (u.seg > 0) { float t[8]; unpack8(Tq[m][bj], t);
#pragma unroll
                        for (int e = 0; e < 4; ++e) { v0[e] += t[e]; v1[e] += t[4 + e]; } }
                    u32x4 w; w.x = cvt_pk_bf16(v0[0], v0[1]); w.y = cvt_pk_bf16(v0[2], v0[3]); w.z = cvt_pk_bf16(v1[0], v1[1]); w.w = cvt_pk_bf16(v1[2], v1[3]);
                    if (u.seg < 2) *(u32x4*)(tmp + row * DM + col) = w; else *(u32x4*)(merged + row * DM + col) = w; }
            asm volatile("" ::: "memory"); }
    } };
struct SchedP3 { unsigned proj, Wc; int G, c;
    __device__ __forceinline__ bool next(int i, Unit& u) const {
        const int ti = i / 2, seg = 1 + (i - 2 * ti), L = ti * G + c; constexpr int nM = M / BM, nN = DM / BM;
        if (L >= nM * nN) return false;
        tile_of(L, nM, nN, u.pm, u.pn); u.seg = seg;
        const int acol = seg == 0 ? PC_BG : (seg == 1 ? PC_FQ : PC_MQ);
        u.A = proj + ((unsigned)u.pm * BM * PJ + acol) * 2; u.B = Wc + ((unsigned)seg * DM * 1024 + (unsigned)u.pn * BM * 1024) * 2; return true; } };

struct SchedG { unsigned A, B; int lda, ldb, nM, nN, G, c;
    __device__ __forceinline__ bool next(int i, Unit& u) const {
        const int L = i * G + c; if (L >= nM * nN) return false;
        tile_of(L, nM, nN, u.pm, u.pn); u.seg = 0; u.A = A + (unsigned)u.pm * BM * lda * 2; u.B = B + (unsigned)u.pn * BM * ldb * 2; return true; } };

struct EpiP4 { const float* x; bf16_t* x1b; float* ssp;
    __device__ __forceinline__ void operator()(Acc& acc, const Unit& u, int wr, int wc, int fr, int fq, PG8_LAS unsigned char*) const {
        asm volatile("" : "+v"(fr), "+v"(fq));
        const int row0 = u.pm * BM + wr * 64 + fr, col0 = u.pn * BM + wc * 32 + 8 * fq;
#pragma unroll
        for (int ai = 0; ai < 2; ++ai)
#pragma unroll
            for (int mh = 0; mh < 2; ++mh) { f32x4 X[2][2][2];
#pragma unroll
                for (int m2 = 0; m2 < 2; ++m2)
#pragma unroll
                    for (int bj = 0; bj < 2; ++bj) { const size_t off = (size_t)(row0 + ai * HALF + (mh * 2 + m2) * 16) * DM + col0 + bj * HALF; X[m2][bj][0] = *(const f32x4*)(x + off); X[m2][bj][1] = *(const f32x4*)(x + off + 4); }
#pragma unroll
                for (int m2 = 0; m2 < 2; ++m2) { const int m = mh * 2 + m2; const size_t row = (size_t)(row0 + ai * HALF + m * 16); float s = 0.f;
#pragma unroll
                    for (int bj = 0; bj < 2; ++bj) { const size_t off = row * DM + col0 + bj * HALF;
                        const f32x4 v0 = acc[ai][bj][m][0] + X[m2][bj][0], v1 = acc[ai][bj][m][1] + X[m2][bj][1];
                        u32x4 w; w.x = cvt_pk_bf16(v0[0], v0[1]); w.y = cvt_pk_bf16(v0[2], v0[3]); w.z = cvt_pk_bf16(v1[0], v1[1]); w.w = cvt_pk_bf16(v1[2], v1[3]);
                        *(u32x4*)(x1b + off) = w;
                        s += (v0[0] * v0[0] + v0[1] * v0[1]) + (v0[2] * v0[2] + v0[3] * v0[3]) + (v1[0] * v1[0] + v1[1] * v1[1]) + (v1[2] * v1[2] + v1[3] * v1[3]); }
                    s += __shfl_xor(s, 16); s += __shfl_xor(s, 32);
                    if (fq == 0) ssp[row * 32 + u.pn * 4 + wc] = s; }
                asm volatile("" ::: "memory"); }
    } };
struct EpiP5 { const float* ssp; bf16_t* U;
    __device__ __forceinline__ void operator()(Acc& acc, const Unit& u, int wr, int wc, int fr, int fq, PG8_LAS unsigned char*) const {
        const int row0 = u.pm * BM + wr * 64 + fr, col0 = u.pn * BM + wc * 32 + 8 * fq;
#pragma unroll
        for (int ai = 0; ai < 2; ++ai)
#pragma unroll
            for (int m = 0; m < 4; ++m) { const size_t row = (size_t)(row0 + ai * HALF + m * 16);
                const f32x4 p0 = *(const f32x4*)(ssp + row * 32 + fq * 8), p1 = *(const f32x4*)(ssp + row * 32 + fq * 8 + 4);
                float s = (p0[0] + p0[1]) + (p0[2] + p0[3]) + (p1[0] + p1[1]) + (p1[2] + p1[3]);
                s += __shfl_xor(s, 16); s += __shfl_xor(s, 32);
                const float r = rsqrtf(s * (1.f / DM) + EPS);
#pragma unroll
                for (int bj = 0; bj < 2; ++bj) { f32x4 v0 = acc[ai][bj][m][0] * r, v1 = acc[ai][bj][m][1] * r;
#pragma unroll
                    for (int e = 0; e < 4; ++e) { v0[e] = fmaxf(v0[e], 0.f); v0[e] *= v0[e]; v1[e] = fmaxf(v1[e], 0.f); v1[e] *= v1[e]; }
                    u32x4 w; w.x = cvt_pk_bf16(v0[0], v0[1]); w.y = cvt_pk_bf16(v0[2], v0[3]); w.z = cvt_pk_bf16(v1[0], v1[1]); w.w = cvt_pk_bf16(v1[2], v1[3]);
                    *(u32x4*)(U + row * DFF + col0 + bj * HALF) = w; } }
    } };
struct EpiP6 { float* out; const bf16_t* x1b;
    __device__ __forceinline__ void operator()(Acc& acc, const Unit& u, int wr, int wc, int fr, int fq, PG8_LAS unsigned char*) const {
        asm volatile("" : "+v"(fr), "+v"(fq));
        const int row0 = u.pm * BM + wr * 64 + fr, col0 = u.pn * BM + wc * 32 + 8 * fq;
#pragma unroll
        for (int ai = 0; ai < 2; ++ai) { u32x4 Tq[4][2];
#pragma unroll
            for (int m = 0; m < 4; ++m)
#pragma unroll
                for (int bj = 0; bj < 2; ++bj) Tq[m][bj] = *(const u32x4*)(x1b + (size_t)(row0 + ai * HALF + m * 16) * DM + col0 + bj * HALF);
#pragma unroll
            for (int m = 0; m < 4; ++m)
#pragma unroll
                for (int bj = 0; bj < 2; ++bj) { const size_t off = (size_t)(row0 + ai * HALF + m * 16) * DM + col0 + bj * HALF;
                    float t[8]; unpack8(Tq[m][bj], t);
                    f32x4 v0 = acc[ai][bj][m][0], v1 = acc[ai][bj][m][1];
#pragma unroll
                    for (int e = 0; e < 4; ++e) { v0[e] += t[e]; v1[e] += t[4 + e]; }
                    *(f32x4*)(out + off) = v0; *(f32x4*)(out + off + 4) = v1; }
            asm volatile("" ::: "memory"); }
    } };
struct EpiMemS { bf16_t* PM;
    __device__ __forceinline__ void operator()(Acc& acc, const Unit& u, int wr, int wc, int fr, int fq, PG8_LAS unsigned char* lds) const {
        PG8_LAS float* X1 = (PG8_LAS float*)(lds + XCH_OFF); PG8_LAS float* X2 = X1 + 1024;
#pragma unroll
        for (int ai = 0; ai < 2; ++ai)
#pragma unroll
            for (int m = 0; m < 4; ++m) { float v = -INFINITY;
#pragma unroll
                for (int bj = 0; bj < 2; ++bj)
#pragma unroll
                    for (int n = 0; n < 2; ++n)
#pragma unroll
                        for (int e = 0; e < 4; ++e) v = fmaxf(v, acc[ai][bj][m][n][e]);
                v = fmaxf(v, __shfl_xor(v, 16)); v = fmaxf(v, __shfl_xor(v, 32));
                if (fq == 0) X1[(ai * HALF + wr * 64 + m * 16 + fr) * 4 + wc] = v; }
        asm volatile("s_waitcnt lgkmcnt(0)" ::: "memory"); __builtin_amdgcn_s_barrier(); asm volatile("" ::: "memory");
#pragma unroll
        for (int ai = 0; ai < 2; ++ai)
#pragma unroll
            for (int m = 0; m < 4; ++m) { const int rl = ai * HALF + wr * 64 + m * 16 + fr;
                const f32x4 t = *(PG8_LAS const f32x4*)(X1 + rl * 4); const float mx = fmaxf(fmaxf(t[0], t[1]), fmaxf(t[2], t[3]));
                float s = 0.f;
#pragma unroll
                for (int bj = 0; bj < 2; ++bj)
#pragma unroll
                    for (int n = 0; n < 2; ++n)
#pragma unroll
                        for (int e = 0; e < 4; ++e) { const float p = __builtin_amdgcn_exp2f(acc[ai][bj][m][n][e] - mx); acc[ai][bj][m][n][e] = p; s += p; }
                s += __shfl_xor(s, 16); s += __shfl_xor(s, 32);
                if (fq == 0) X2[rl * 4 + wc] = s; }
        asm volatile("s_waitcnt lgkmcnt(0)" ::: "memory"); __builtin_amdgcn_s_barrier(); asm volatile("" ::: "memory");
        const int row0 = u.pm * BM, col0 = u.seg * MT + wc * 32 + 8 * fq;
#pragma unroll
        for (int ai = 0; ai < 2; ++ai)
#pragma unroll
            for (int m = 0; m < 4; ++m) { const int rl = ai * HALF + wr * 64 + m * 16 + fr;
                const f32x4 t = *(PG8_LAS const f32x4*)(X2 + rl * 4); const float r = 1.f / ((t[0] + t[1]) + (t[2] + t[3]));
#pragma unroll
                for (int bj = 0; bj < 2; ++bj) { const f32x4 v0 = acc[ai][bj][m][0] * r, v1 = acc[ai][bj][m][1] * r;
                    u32x4 w; w.x = cvt_pk_bf16(v0[0], v0[1]); w.y = cvt_pk_bf16(v0[2], v0[3]); w.z = cvt_pk_bf16(v1[0], v1[1]); w.w = cvt_pk_bf16(v1[2], v1[3]);
                    *(u32x4*)(PM + (size_t)(row0 + rl) * 1024 + col0 + bj * HALF) = w; } }
    } };
struct EpiPlain { bf16_t* base; int ldc;
    __device__ __forceinline__ void operator()(Acc& acc, const Unit& u, int wr, int wc, int fr, int fq, PG8_LAS unsigned char*) const {
        const int row0 = u.pm * BM + wr * 64 + fr, col0 = u.pn * BM + wc * 32 + 8 * fq;
#pragma unroll
        for (int ai = 0; ai < 2; ++ai)
#pragma unroll
            for (int m = 0; m < 4; ++m) { bf16_t* rowp = base + (size_t)(row0 + ai * HALF + m * 16) * ldc + col0;
#pragma unroll
                for (int bj = 0; bj < 2; ++bj) { const f32x4 v0 = acc[ai][bj][m][0], v1 = acc[ai][bj][m][1];
                    u32x4 w; w.x = cvt_pk_bf16(v0[0], v0[1]); w.y = cvt_pk_bf16(v0[2], v0[3]); w.z = cvt_pk_bf16(v1[0], v1[1]); w.w = cvt_pk_bf16(v1[2], v1[3]);
                    *(u32x4*)(rowp + bj * HALF) = w; } }
    } };
struct SchedOne { Unit u; __device__ __forceinline__ bool next(int i, Unit& o) const { if (i) return false; o = u; return true; } };
}


namespace fox {
#define FLAS __attribute__((address_space(3)))
constexpr int NW = 8, QBLK = 32, KVBLK = 64, QB = NW * QBLK, D = 128;
constexpr int SHM_V = KVBLK * D * 2, SHM_K = KVBLK * D * 2;
constexpr int OFF_V = 0, OFF_K = 2 * SHM_V, OFF_WS = OFF_K + 2 * SHM_K, OFF_C = OFF_WS + NW * 64 * 4, LDS_NEED = OFF_C + SEQ * 4;
constexpr float THR2 = 8.f * LOG2E;
#define KSWZ(row, colB) ((row) * 256 + ((colB) ^ (((row) & 7) << 4)))
#define SBAR() __builtin_amdgcn_sched_barrier(0)
__device__ __forceinline__ int v_st(int k, int c) { const int kk = (k & ~0xC) | ((k & 4) << 1) | ((k & 8) >> 1); return ((kk >> 3) * 4 + (c >> 5)) * 512 + ((kk & 7) * 32 + (c & 31)) * 2; }
__device__ __forceinline__ int v_rd_base(int lane) { return ((lane & 3) << 3) | (((lane >> 2) & 3) << 6) | (((lane >> 4) & 1) << 5) | (((lane >> 5) & 1) << 8); }
constexpr int v_rd_off(int d0, int ks, int half) { return d0 * 512 + ks * 4096 + half * 2048; }
__device__ __forceinline__ int crow(int r, int hi) { return (r & 3) + 8 * (r >> 2) + 4 * hi; }
__device__ __forceinline__ unsigned cvtpk(float lo, float hi) { unsigned r; asm volatile("v_cvt_pk_bf16_f32 %0, %1, %2" : "=v"(r) : "v"(lo), "v"(hi)); return r; }
typedef short s16x4 __attribute__((ext_vector_type(4)));
__device__ __forceinline__ void mask_tile(f32x16& p0, f32x16& p1, int dq) {
    const float NEG = -__builtin_inff();
#pragma unroll
    for (int r = 0; r < 16; ++r) { const int c = (r & 3) + 8 * (r >> 2); if (dq - c < 0) p0[r] = NEG; if (dq - c - 32 < 0) p1[r] = NEG; }
}
__device__ __forceinline__ void partialSM(f32x16& p0, f32x16& p1, float& m_reg, float& mn, float& alpha) {
    float pmax = p0[0];
#pragma unroll
    for (int r = 1; r < 16; ++r) pmax = fmaxf(pmax, p0[r]);
#pragma unroll
    for (int r = 0; r < 16; ++r) pmax = fmaxf(pmax, p1[r]);
    { auto rr = __builtin_amdgcn_permlane32_swap(__float_as_uint(pmax), __float_as_uint(pmax), false, false);
      pmax = fmaxf(__uint_as_float(rr[0]), __uint_as_float(rr[1])); }
    if (__builtin_expect(__all((pmax - m_reg) <= THR2), 1)) { mn = m_reg; alpha = 1.f; }
    else { mn = fmaxf(m_reg, pmax); alpha = __builtin_amdgcn_exp2f(m_reg - mn); m_reg = mn; }
#pragma unroll
    for (int r = 0; r < 16; ++r) p0[r] = p0[r] - mn;
#pragma unroll
    for (int r = 0; r < 16; ++r) p1[r] = p1[r] - mn;
#pragma unroll
    for (int r = 0; r < 16; ++r) p0[r] = __builtin_amdgcn_exp2f(p0[r]);
}
__device__ __forceinline__ void finishSM(f32x16& p0, f32x16& p1, float alpha, float& l_reg, bf16x8& pa0, bf16x8& pa1, bf16x8& pa2, bf16x8& pa3) {
#pragma unroll
    for (int r = 0; r < 16; ++r) p1[r] = __builtin_amdgcn_exp2f(p1[r]);
    float ps = 0;
#pragma unroll
    for (int r = 0; r < 16; ++r) ps += p0[r];
#pragma unroll
    for (int r = 0; r < 16; ++r) ps += p1[r];
    { auto rr = __builtin_amdgcn_permlane32_swap(__float_as_uint(ps), __float_as_uint(ps), false, false);
      ps = __uint_as_float(rr[0]) + __uint_as_float(rr[1]); }
    l_reg = l_reg * alpha + ps;
#define PK4(P, B_, OUT) do { unsigned a0 = cvtpk(P[B_+0], P[B_+1]), a1 = cvtpk(P[B_+2], P[B_+3]);                          \
        unsigned b0 = cvtpk(P[B_+4], P[B_+5]), b1 = cvtpk(P[B_+6], P[B_+7]);                                             \
        auto r0 = __builtin_amdgcn_permlane32_swap(a0, b0, false, false); auto r1 = __builtin_amdgcn_permlane32_swap(a1, b1, false, false); \
        u32x4 w = {r0[0], r1[0], r0[1], r1[1]}; OUT = __builtin_bit_cast(bf16x8, w); } while (0)
    PK4(p0, 0, pa0); PK4(p0, 8, pa1); PK4(p1, 0, pa2); PK4(p1, 8, pa3);
#undef PK4
}
template <int KB>
__device__ __forceinline__ void qkt(f32x16& p0, f32x16& p1, FLAS const char* K_lds, FLAS const float* ctile, int r32, int hi, const bf16x8* qr) {
    FLAS const float* cl = ctile + 4 * hi;
#pragma unroll
    for (int g = 0; g < 4; ++g) { const f32x4 a = *(FLAS const f32x4*)(cl + 8 * g), b = *(FLAS const f32x4*)(cl + 32 + 8 * g);
#pragma unroll
        for (int e = 0; e < 4; ++e) { p0[4 * g + e] = a[e]; p1[4 * g + e] = b[e]; } }
    FLAS const char* kb[4];
#pragma unroll
    for (int dd = 0; dd < 4; ++dd) kb[dd] = K_lds + KB * SHM_K + KSWZ(r32, (dd * 16 + hi * 8) * 2);
#pragma unroll
    for (int d0 = 0; d0 < 8; ++d0) { FLAS const char* a = kb[d0 & 3] + (d0 >> 2) * 128;
        const bf16x8 b0 = *(FLAS const bf16x8*)(a);
        const bf16x8 b1 = *(FLAS const bf16x8*)(a + 32 * 256);
        p0 = __builtin_amdgcn_mfma_f32_32x32x16_bf16(b0, qr[d0], p0, 0, 0, 0);
        p1 = __builtin_amdgcn_mfma_f32_32x32x16_bf16(b1, qr[d0], p1, 0, 0, 0); }
}
template <int VB>
__device__ __forceinline__ void pv_tile(f32x16* o, int vb0, bf16x8 pa0, bf16x8 pa1, bf16x8 pa2, bf16x8 pa3) {
#define TRRD(dst, off) asm volatile("ds_read_b64_tr_b16 %0, %1 offset:%2" : "=&v"(dst) : "v"(vb0), "i"(off) : "memory")
#define PV_D0(d0) do { s16x4 l0, l1, l2, l3, h0, h1, h2, h3; constexpr int b_ = OFF_V + VB * SHM_V + v_rd_off(d0, 0, 0); \
        TRRD(l0, b_); TRRD(h0, b_ + 2048); TRRD(l1, b_ + 4096); TRRD(h1, b_ + 6144); TRRD(l2, b_ + 8192); TRRD(h2, b_ + 10240); TRRD(l3, b_ + 12288); TRRD(h3, b_ + 14336); \
        asm volatile("s_waitcnt lgkmcnt(0)" ::: "memory"); SBAR();   \
        o[d0] = __builtin_amdgcn_mfma_f32_32x32x16_bf16(pa0, (bf16x8){l0[0], l0[1], l0[2], l0[3], h0[0], h0[1], h0[2], h0[3]}, o[d0], 0, 0, 0);   \
        o[d0] = __builtin_amdgcn_mfma_f32_32x32x16_bf16(pa1, (bf16x8){l1[0], l1[1], l1[2], l1[3], h1[0], h1[1], h1[2], h1[3]}, o[d0], 0, 0, 0);   \
        o[d0] = __builtin_amdgcn_mfma_f32_32x32x16_bf16(pa2, (bf16x8){l2[0], l2[1], l2[2], l2[3], h2[0], h2[1], h2[2], h2[3]}, o[d0], 0, 0, 0);   \
        o[d0] = __builtin_amdgcn_mfma_f32_32x32x16_bf16(pa3, (bf16x8){l3[0], l3[1], l3[2], l3[3], h3[0], h3[1], h3[2], h3[3]}, o[d0], 0, 0, 0); } while (0)
    PV_D0(0); PV_D0(1); PV_D0(2); PV_D0(3);
#undef PV_D0
#undef TRRD
}
struct BlockRef { bf16_t* base; int P0; };
struct Seam { bf16x8 qr[8]; bf16x8 st_v0, st_v1, st_k0, st_k1; };
#define VMW() asm volatile("s_waitcnt vmcnt(0)" ::: "memory")
#define VMWN(n) asm volatile("s_waitcnt vmcnt(%0)" :: "i"(n) : "memory")
#define LD8(p) (*(const bf16x8*)(p))
#define FRESH(t_) int t_ = threadIdx.x; asm volatile("" : "+v"(t_))
#define SLOAD_H(Bp, k0) do { FRESH(t_); const unsigned toff_ = (unsigned)((t_ >> 4) * PJ + (t_ & 15) * 8); const bf16_t* tk_ = (Bp) + PC_FK + (size_t)(k0) * PJ; const bf16_t* tv_ = (Bp) + PC_FV + (size_t)(k0) * PJ; \
        S.st_v0 = LD8(tv_ + toff_); S.st_v1 = LD8(tv_ + 32 * PJ + toff_); S.st_k0 = LD8(tk_ + toff_); S.st_k1 = LD8(tk_ + 32 * PJ + toff_); } while (0)
#define SWRITE_HK(bf) do { FRESH(t_); const int kws_ = KSWZ(t_ >> 4, (t_ & 15) * 16); *(FLAS bf16x8*)(K_lds + (bf) * SHM_K + kws_) = S.st_k0; *(FLAS bf16x8*)(K_lds + (bf) * SHM_K + kws_ + 32 * 256) = S.st_k1; } while (0)
#define SWRITE_HV(bf) do { FRESH(t_); const int vst0_ = v_st(t_ >> 4, (t_ & 15) * 8), vst1_ = v_st(32 + (t_ >> 4), (t_ & 15) * 8); *(FLAS bf16x8*)(V_lds + (bf) * SHM_V + vst0_) = S.st_v0; *(FLAS bf16x8*)(V_lds + (bf) * SHM_V + vst1_) = S.st_v1; } while (0)
#define SWRITE_H(bf) do { SWRITE_HV(bf); SWRITE_HK(bf); } while (0)
__device__ __forceinline__ int prime(const BlockRef& cur, const float* nck, const float* fqg, const float* fkg, FLAS char* lds, Seam& S) {
    int tid_ = threadIdx.x; asm volatile("" : "+v"(tid_));
    const int tid = tid_, wid = __builtin_amdgcn_readfirstlane(tid >> 6), lane = tid & 63, r32 = lane & 31, hi = lane >> 5;
    FLAS char* K_lds = lds + OFF_K; FLAS float* C_lds = (FLAS float*)(lds + OFF_C);
    const unsigned qoff = (unsigned)(r32 * PJ + hi * 8);
    { const f32x4 c0 = *(const f32x4*)(nck + 4 * tid), c1 = *(const f32x4*)(nck + 2048 + 4 * tid); *(FLAS f32x4*)(C_lds + 4 * tid) = c0; *(FLAS f32x4*)(C_lds + 2048 + 4 * tid) = c1; }
#pragma unroll
    for (int d0 = 0; d0 < 8; ++d0) S.qr[d0] = LD8(cur.base + PC_FQ + (size_t)(cur.P0 + wid * QBLK) * PJ + d0 * 16 + qoff);
    __syncthreads();
    const float gq = fmaxf(fabsf(fqg[lane]), fabsf(fqg[lane + 64])), gk = fmaxf(fabsf(fkg[lane]), fabsf(fkg[lane + 64]));
    const float thresh = 2.f * (1.02f * C2F * FD * wave_max(gq) * wave_max(gk)) + 40.f;
    const float cP0 = C_lds[cur.P0], ct = C_lds[64 * lane + 63];
    const int j_lo = __builtin_amdgcn_readfirstlane(__popcll(__ballot(cP0 - ct > thresh)));
    SLOAD_H(cur.base, j_lo * KVBLK); VMW(); SWRITE_HK(0);
    __syncthreads();
    return j_lo;
}
__device__ __forceinline__ void block(const BlockRef& cur, const int j_lo, FLAS char* lds, Seam& S) {
    int tid_ = threadIdx.x; asm volatile("" : "+v"(tid_));
    const int tid = tid_, wid = __builtin_amdgcn_readfirstlane(tid >> 6), lane = tid & 63, r32 = lane & 31, hi = lane >> 5;
    const int NT = cur.P0 / KVBLK + 4 - j_lo;
    const int qlo = cur.P0 + wid * QBLK;
    FLAS char* V_lds = lds + OFF_V; FLAS char* K_lds = lds + OFF_K; FLAS float* C_lds = (FLAS float*)(lds + OFF_C);
    FLAS float* ws = (FLAS float*)(lds + OFF_WS) + wid * 64; FLAS float* li_l = ws; FLAS float* al_l = ws + 32;
    float m_reg = -1e30f, l_reg = 0; f32x16 o[4] = {};
    const bf16_t* Bh = cur.base;
#define RESC(a) do { if (__any((a) < 1.f)) { if (hi == 0) al_l[r32] = (a); asm volatile("s_waitcnt lgkmcnt(0)" ::: "memory");              \
                     _Pragma("unroll") for (int d_ = 0; d_ < 4; ++d_) _Pragma("unroll") for (int r = 0; r < 16; ++r) o[d_][r] *= al_l[crow(r, hi)]; } } while (0)
#define KBASE(t) ((j_lo + (t)) * KVBLK)
#define MASKT(P0_, P1_, t) do { const int kb_ = KBASE(t); if (kb_ + KVBLK - 1 > qlo) { FRESH(tm_); mask_tile(P0_, P1_, qlo + (tm_ & 31) - 4 * ((tm_ >> 5) & 1) - kb_); } } while (0)
#define VB0() ({ FRESH(tv_); (int)(uintptr_t)lds + v_rd_base(tv_ & 63); })
    f32x16 pA0, pA1, pB0, pB1; float mnA, mnB, alA, alB; bf16x8 pa0, pa1, pa2, pa3;
    SWRITE_HV(0); SBAR();
    if (NT > 1) { SLOAD_H(Bh, KBASE(1)); }
    SBAR(); qkt<0>(pA0, pA1, K_lds, C_lds + KBASE(0), r32, hi, S.qr);
    MASKT(pA0, pA1, 0); partialSM(pA0, pA1, m_reg, mnA, alA);
    if (NT > 1) { VMW(); SWRITE_H(1); }
    __syncthreads();
#define HALF_STEP(PX0, PX1, mnX, alX, PY0, PY1, alY, t, KB, VB, SB) do {                                                      \
        SBAR(); qkt<KB>(PX0, PX1, K_lds, C_lds + KBASE(t), r32, hi, S.qr);                                                    \
        finishSM(PY0, PY1, alY, l_reg, pa0, pa1, pa2, pa3); SBAR();                                                           \
        if ((t) + 1 < NT) { SLOAD_H(Bh, KBASE((t) + 1)); SBAR(); }                                                            \
        pv_tile<VB>(o, VB0(), pa0, pa1, pa2, pa3); MASKT(PX0, PX1, (t)); partialSM(PX0, PX1, m_reg, mnX, alX);                   \
        __syncthreads();                                                                                                      \
        if ((t) + 1 < NT) { VMW(); SWRITE_H(SB); }                                                                            \
        RESC(alX); __syncthreads(); } while (0)
    for (int t = 1; t + 1 < NT; t += 2) {
        HALF_STEP(pB0, pB1, mnB, alB, pA0, pA1, alA, t, 1, 0, 0);
        HALF_STEP(pA0, pA1, mnA, alA, pB0, pB1, alB, t + 1, 0, 1, 1);
    }
    const bool even = (NT & 1) == 0;
    if (even) { SBAR(); qkt<1>(pB0, pB1, K_lds, C_lds + KBASE(NT - 1), r32, hi, S.qr); SBAR(); }
    finishSM(pA0, pA1, alA, l_reg, pa0, pa1, pa2, pa3); SBAR();
    pv_tile<0>(o, VB0(), pa0, pa1, pa2, pa3);
    if (even) { MASKT(pB0, pB1, NT - 1); partialSM(pB0, pB1, m_reg, mnB, alB); __syncthreads(); RESC(alB);
        finishSM(pB0, pB1, alB, l_reg, pa0, pa1, pa2, pa3); SBAR(); pv_tile<1>(o, VB0(), pa0, pa1, pa2, pa3); }
    if (hi == 0) li_l[r32] = l_reg; asm volatile("s_waitcnt lgkmcnt(0)" ::: "memory");
    float rli[16];
#pragma unroll
    for (int r = 0; r < 16; ++r) rli[r] = __builtin_amdgcn_rcpf(li_l[crow(r, hi)]);
    bf16_t* Ow = cur.base + PC_FQ + (size_t)(cur.P0 + wid * QBLK) * PJ;
#pragma unroll
    for (int r = 0; r < 16; ++r) { const int orow = crow(r, hi);
#pragma unroll
        for (int d0 = 0; d0 < 4; ++d0) { const float v = o[d0][r] * rli[r];
            const float vn = __shfl_xor(v, 1);
            if ((r32 & 1) == 0) *(unsigned*)(Ow + (unsigned)(orow * PJ + d0 * 32 + r32)) = cvtpk(v, vn); } }
    __syncthreads();
#undef RESC
#undef KBASE
#undef MASKT
#undef VB0
#undef HALF_STEP
}
#undef VMW
#undef VMWN
#undef LD8
#undef SLOAD_H
#undef SWRITE_HK
#undef SWRITE_HV
#undef SWRITE_H
#undef FRESH
#undef SBAR
#undef KSWZ
__device__ __forceinline__ void phase_item(FLAS char* lds, bf16_t* proj, const float* nck, const float* fqg, const float* fkg, int bh, int qb) {
    Seam S;
    const BlockRef cur{proj + (size_t)(bh >> 3) * SEQ * PJ + (bh & 7) * FD, qb * QB};
    const int j_lo = prime(cur, nck + (size_t)bh * SEQ, fqg, fkg, lds, S);
    block(cur, j_lo, lds, S);
}
}

constexpr int NWAVES = 8, LDS_BYTES = 147456, RING_BYTES = 131072, MISC_OFF = RING_BYTES + 320;
#define GAS __attribute__((address_space(1)))
#define LAS __attribute__((address_space(3)))
#define XB_TMO      128
#define XB_XCNT(j)  (256  + 64 * (j))
#define XB_XSUB(j)  (1280 + 64 * (j))
#define XB_XGEN(j)  (2304 + 64 * (j))
#define XB_TOP      3328
#define XB_TOPGEN   3392
#define XCD_BAR_WORDS 3456
#define XB_SPIN_CAP (1u << 18)
__device__ __forceinline__ unsigned xb_ld(unsigned* p)              { return __hip_atomic_load(p, __ATOMIC_RELAXED, __HIP_MEMORY_SCOPE_AGENT); }
__device__ __forceinline__ unsigned xb_add(unsigned* p, unsigned v) { return __hip_atomic_fetch_add(p, v, __ATOMIC_RELAXED, __HIP_MEMORY_SCOPE_AGENT); }
__device__ __forceinline__ unsigned xb_xcc_id() { return (unsigned)__builtin_amdgcn_s_getreg((3 << 11) | 20) & 0xFu; }
#define XB_SPIN(cond, bar) do { unsigned _sp = 0; while (cond) { __builtin_amdgcn_s_sleep(1); \
    if ((++_sp & 255u) == 0u) { if (xb_ld(&(bar)[XB_TMO])) break; if (_sp > XB_SPIN_CAP) { atomicAdd(&(bar)[XB_TMO], 1u); break; } } } } while (0)
struct XcdBarrier { unsigned* bar; unsigned x; volatile LAS unsigned* st; };
__device__ __forceinline__ XcdBarrier xcd_barrier_post(unsigned* bar, volatile LAS unsigned* st) {
    XcdBarrier b; b.bar = bar; b.x = xb_xcc_id(); b.st = st;
    if (threadIdx.x == 0) (void)xb_add(&bar[XB_XCNT(b.x)], 1u);
    return b;
}
__device__ __forceinline__ void xcd_barrier_complete(unsigned* bar, unsigned x, unsigned& nloc, unsigned& nx) {
    const unsigned G = gridDim.x * gridDim.y * gridDim.z;
    unsigned sum, cnt, mine, sp = 0u;
    for (;;) {
        sum = 0u; cnt = 0u; mine = 0u;
#pragma unroll
        for (unsigned j = 0; j < 16; ++j) { const unsigned c = xb_ld(&bar[XB_XCNT(j)]); sum += c; cnt += (c > 0u) ? 1u : 0u; mine = (j == x) ? c : mine; }
        if (sum == G) break;
        __builtin_amdgcn_s_sleep(1);
        if ((++sp & 255u) == 0u) { if (xb_ld(&bar[XB_TMO])) break; if (sp > XB_SPIN_CAP) { atomicAdd(&bar[XB_TMO], 1u); break; } }
    }
    nloc = mine > 0u ? mine : 1u; nx = cnt > 0u ? cnt : 1u;
}
__device__ __forceinline__ void xcd_barrier(const XcdBarrier& b) {
    asm volatile("s_waitcnt vmcnt(0)" ::: "memory");
    __syncthreads();
    if (threadIdx.x == 0) {
        unsigned* bar = b.bar;
        __builtin_amdgcn_s_waitcnt(0);
        unsigned nloc = b.st[0], nx = b.st[1];
        if (nloc == 0u) { xcd_barrier_complete(bar, b.x, nloc, nx); b.st[0] = nloc; b.st[1] = nx; }
        const unsigned old = xb_add(&bar[XB_XSUB(b.x)], 1u);
        const unsigned gen = old / nloc;
        if (old + 1u == (gen + 1u) * nloc) {
            __builtin_amdgcn_fence(__ATOMIC_RELEASE, "agent");
            asm volatile("s_waitcnt vmcnt(0)" ::: "memory");
            const unsigned og = xb_add(&bar[XB_TOP], 1u);
            const unsigned tg = og / nx;
            if (og + 1u == (tg + 1u) * nx) xb_add(&bar[XB_TOPGEN], 1u);
            else XB_SPIN(xb_ld(&bar[XB_TOPGEN]) == tg, bar);
            __builtin_amdgcn_fence(__ATOMIC_ACQUIRE, "agent");
            xb_add(&bar[XB_XGEN(b.x)], 1u);
            asm volatile("s_waitcnt vmcnt(0)" ::: "memory");
        } else {
            XB_SPIN(xb_ld(&bar[XB_XGEN(b.x)]) == gen, bar);
            __builtin_amdgcn_fence(__ATOMIC_ACQUIRE, "agent");
            asm volatile("s_waitcnt vmcnt(0)" ::: "memory");
        }
    }
    __syncthreads();
}

struct TrRegs { f32x4 v[16]; };
__device__ __forceinline__ void p0_tr_load(TrRegs& R, const float* __restrict__ W, int ldw, int nblk, int remap, int item, int lane) {
    const int kb = item / nblk, nb = item - kb * nblk, k0 = 64 * kb, n0 = 64 * nb;
    const int src0 = n0 + ((remap && n0 >= OC_FL) ? 8 : 0);
    const int kr = lane >> 4, nc = (lane & 15) * 4;
    const float* wp = W + (size_t)(k0 + 2 * kr) * ldw + src0 + nc;
#pragma unroll
    for (int i = 0; i < 8; ++i) { R.v[2 * i] = __builtin_nontemporal_load((const f32x4*)(wp + (size_t)(8 * i) * ldw)); R.v[2 * i + 1] = __builtin_nontemporal_load((const f32x4*)(wp + (size_t)(8 * i + 1) * ldw)); }
}
__device__ __forceinline__ void p0_tr_store(const TrRegs& R, int K, int nblk, const float* __restrict__ g, bf16_t* __restrict__ WT, int row_off, LAS unsigned* scr, int item, int lane) {
    const int kb = item / nblk, nb = item - kb * nblk, k0 = 64 * kb, n0 = 64 * nb;
    const int kr = lane >> 4, nc = (lane & 15) * 4;
#pragma unroll
    for (int i = 0; i < 8; ++i) {
        float g0 = 1.f, g1 = 1.f; if (g) { g0 = g[k0 + 8 * i + 2 * kr]; g1 = g[k0 + 8 * i + 2 * kr + 1]; }
        const int kp = 4 * i + kr;
#pragma unroll
        for (int e = 0; e < 4; ++e) scr[(nc + e) * 33 + kp] = pk2(R.v[2 * i][e] * g0, R.v[2 * i + 1][e] * g1);
    }
    asm volatile("s_waitcnt lgkmcnt(0)" ::: "memory");
    const int cch = lane & 7;
#pragma unroll
    for (int j = 0; j < 8; ++j) { const int n = (lane >> 3) + 8 * j; const LAS unsigned* s = scr + n * 33 + 4 * cch;
        u32x4 o; o.x = s[0]; o.y = s[1]; o.z = s[2]; o.w = s[3];
        *(u32x4*)(WT + (size_t)(row_off + n0 + n) * K + k0 + 8 * cch) = o; }
    asm volatile("s_waitcnt lgkmcnt(0)" ::: "memory");
}
__device__ __forceinline__ void p0_transpose_item(const float* __restrict__ W, int ldw, int K, int nblk, const float* __restrict__ g, bf16_t* __restrict__ WT, int row_off, int remap, LAS unsigned* scr, int item, int lane) {
    TrRegs R; p0_tr_load(R, W, ldw, nblk, remap, item, lane); p0_tr_store(R, K, nblk, g, WT, row_off, scr, item, lane);
}
struct RowRegs { f32x4 v[8]; };
__device__ __forceinline__ void p0_row_load(RowRegs& R, int row, int lane, const float* __restrict__ x, const float* __restrict__ mem) {
    const float* src = row < M ? x + (size_t)row * DM : mem + (size_t)(row - M) * DM;
#pragma unroll
    for (int j = 0; j < 8; ++j) R.v[j] = __builtin_nontemporal_load((const f32x4*)(src + 256 * j + 4 * lane));
}
__device__ __forceinline__ void p0_row_proc(const RowRegs& R, int row, int lane, const float* __restrict__ b_f, bf16_t* __restrict__ hb, float* __restrict__ lf, const LAS float* wfs) {
    const bool is_x = row < M;
    float ss = 0.f;
#pragma unroll
    for (int j = 0; j < 8; ++j) ss += R.v[j].x * R.v[j].x + R.v[j].y * R.v[j].y + R.v[j].z * R.v[j].z + R.v[j].w * R.v[j].w;
    ss = wave_sum(ss);
    const float r = rsqrtf(ss * (1.f / DM) + EPS);
    bf16_t* dst = hb + (size_t)row * DM;
#pragma unroll
    for (int j = 0; j < 8; ++j) { u32x2 w; w.x = pk2(R.v[j].x * r, R.v[j].y * r); w.y = pk2(R.v[j].z * r, R.v[j].w * r); *(u32x2*)(dst + 256 * j + 4 * lane) = w; }
    if (is_x) {
        float a[8] = {0.f, 0.f, 0.f, 0.f, 0.f, 0.f, 0.f, 0.f};
#pragma unroll
        for (int j = 0; j < 8; ++j)
#pragma unroll
            for (int e = 0; e < 4; ++e) {
                const float xv = R.v[j][e];
                const f32x4 w0 = *(const LAS f32x4*)(wfs + ((((j * 4 + e) * 2 + 0) * 64 + lane) * 4));
                const f32x4 w1 = *(const LAS f32x4*)(wfs + ((((j * 4 + e) * 2 + 1) * 64 + lane) * 4));
                a[0] += xv * w0.x; a[1] += xv * w0.y; a[2] += xv * w0.z; a[3] += xv * w0.w;
                a[4] += xv * w1.x; a[5] += xv * w1.y; a[6] += xv * w1.z; a[7] += xv * w1.w;
            }
#pragma unroll
        for (int cc = 0; cc < 8; ++cc) a[cc] = wave_sum(a[cc]);
        if (lane < 8) {
            float z = 0.f;
#pragma unroll
            for (int cc = 0; cc < 8; ++cc) z = (lane == cc) ? a[cc] : z;
            z = z * r + b_f[lane];
            const float ls = (z >= 0.f) ? -log1pf(expf(-z)) : z - log1pf(expf(z));
            lf[(size_t)row * 8 + lane] = ls;
        }
    }
}

struct Args { const float* in[19]; float* out; unsigned char* ws; int ph_lo, ph_hi; };
constexpr int NPH = 8;
__global__ void __launch_bounds__(NWAVES * 64, 2) mega(Args a) {
    extern __shared__ __attribute__((aligned(16))) unsigned char lds_raw[];
    PG8_LAS unsigned char* lds = (PG8_LAS unsigned char*)lds_raw;
    unsigned char* ws = a.ws;
    const int G = gridDim.x, c = blockIdx.x;
#define FRESH_TID() int tid = threadIdx.x; asm volatile("" : "+v"(tid)); const int lane = tid & 63; const int wave = __builtin_amdgcn_readfirstlane(tid >> 6); (void)lane; (void)wave;
    bf16_t* hb = (bf16_t*)(ws + WS_HB); bf16_t* proj = (bf16_t*)(ws + WS_PROJ); bf16_t* gates = (bf16_t*)(ws + WS_GATES); bf16_t* kv = (bf16_t*)(ws + WS_KV); bf16_t* vmT = (bf16_t*)(ws + WS_VMT); bf16_t* PM = (bf16_t*)(ws + WS_PM);
    float* lf = (float*)(ws + WS_LF); float* nck = (float*)(ws + WS_NCK);
    float* ssp = (float*)(ws + WS_SSP); bf16_t* merged = (bf16_t*)(ws + WS_MERGED); bf16_t* U = (bf16_t*)(ws + WS_U); bf16_t* x1b = (bf16_t*)(ws + WS_X1B);
    volatile LAS unsigned* MISC = (volatile LAS unsigned*)(lds + MISC_OFF);
    if (threadIdx.x < 32) MISC[threadIdx.x] = 0u;
    __syncthreads();
    const bool multi = (a.ph_hi - a.ph_lo) > 1;
    XcdBarrier bar; bar.bar = (unsigned*)(ws + WS_CTL); bar.x = 0; bar.st = nullptr;
    if (multi) bar = xcd_barrier_post((unsigned*)(ws + WS_CTL), MISC + 8);
#define IN(k) (a.ph_lo <= (k) && (k) < a.ph_hi)
#define SEAM(k) do { if (IN(k) && IN((k) + 1)) xcd_barrier(bar); } while (0)
    if (IN(0)) {
        FRESH_TID();
        const float* x = a.in[0]; const float* mem = a.in[1]; const float* g1 = a.in[2]; const float* w_in = a.in[3]; const float* b_f = a.in[4];
        __syncthreads();
        LAS float* wfs = (LAS float*)lds;
        const int gw = c * NWAVES + wave, ngw = G * NWAVES;
        RowRegs cur; int row = gw;
        if (row < M + BATCH * MT) p0_row_load(cur, row, lane, x, mem);
        { f32x4 wa[4], wb[4]; float gg[4];
#pragma unroll
          for (int e = 0; e < 4; ++e) { const int k = 4 * tid + e; const float* p = w_in + (size_t)k * IN_COLS + OC_FL; wa[e] = *(const f32x4*)p; wb[e] = *(const f32x4*)(p + 4); gg[e] = g1[k]; }
          const int j = tid >> 6, l = tid & 63;
#pragma unroll
          for (int e = 0; e < 4; ++e) { *(LAS f32x4*)(wfs + ((((j * 4 + e) * 2 + 0) * 64 + l) * 4)) = wa[e] * gg[e]; *(LAS f32x4*)(wfs + ((((j * 4 + e) * 2 + 1) * 64 + l) * 4)) = wb[e] * gg[e]; } }
        __syncthreads();
        while (row < M + BATCH * MT) {
            RowRegs nxt; const int nrow = row + ngw;
            if (nrow < M + BATCH * MT) p0_row_load(nxt, nrow, lane, x, mem);
            p0_row_proc(cur, row, lane, b_f, hb, lf, wfs);
            cur = nxt; row = nrow;
        }
        __syncthreads();
        LAS unsigned* scr = (LAS unsigned*)(lds + wave * 8448);
        constexpr int I_IN = (DM / 64) * (NPACK / 64), I_KV = (DM / 64) * (2048 / 64), I_C3 = 3 * (1024 / 64) * (DM / 64), I_O = (DM / 64) * (DM / 64);
        constexpr int NITEMS = I_IN + I_KV + I_C3 + I_O;
#define P0_DESC(r, src, ldw, nb, rm, K, gi, dst, ro, it) do { \
            if ((r) < I_IN) { src = 3; ldw = IN_COLS; nb = NPACK / 64; rm = 1; K = DM; gi = 2; dst = WS_WIN; ro = 0; it = (r); } \
            else if ((r) < I_IN + I_KV) { src = 9; ldw = 2048; nb = 2048 / 64; rm = 0; K = DM; gi = 8; dst = WS_WIN; ro = NPACK; it = (r) - I_IN; } \
            else if ((r) < I_IN + I_KV + I_C3) { const int s_ = ((r) - I_IN - I_KV) / (I_C3 / 3); src = 12 + s_; ldw = DM; nb = DM / 64; rm = 0; K = 1024; gi = -1; dst = WS_WC + (size_t)s_ * DM * 1024 * 2; ro = 0; it = (r) - I_IN - I_KV - s_ * (I_C3 / 3); } \
            else { src = 15; ldw = DM; nb = DM / 64; rm = 0; K = DM; gi = -1; dst = WS_WOUT; ro = 0; it = (r) - I_IN - I_KV - I_C3; } } while (0)
        {
            struct P0D { int src, ld, nb, rm, K, gi, ro, it; size_t dst; };
            TrRegs cur_t; int it = gw; P0D dc{3, IN_COLS, NPACK / 64, 1, DM, 2, 0, 0, WS_WIN}, dn = dc;
            if (it < NITEMS) { P0_DESC(it, dc.src, dc.ld, dc.nb, dc.rm, dc.K, dc.gi, dc.dst, dc.ro, dc.it); p0_tr_load(cur_t, a.in[dc.src], dc.ld, dc.nb, dc.rm, dc.it, lane); }
#pragma unroll 1
            while (it < NITEMS) {
                TrRegs nxt_t; const int nit = it + ngw;
                if (nit < NITEMS) { P0_DESC(nit, dn.src, dn.ld, dn.nb, dn.rm, dn.K, dn.gi, dn.dst, dn.ro, dn.it); p0_tr_load(nxt_t, a.in[dn.src], dn.ld, dn.nb, dn.rm, dn.it, lane); }
                p0_tr_store(cur_t, dc.K, dc.nb, dc.gi >= 0 ? a.in[dc.gi] : nullptr, (bf16_t*)(ws + dc.dst), dc.ro, scr, dc.it, lane);
                cur_t = nxt_t; it = nit; dc = dn;
            }
        }
#undef P0_DESC
    }
    SEAM(0);
    if (IN(1)) { pg8::SchedP1 S{(unsigned)WS_HB, (unsigned)WS_WIN, G, c}; pg8::EpiP1 E{proj, gates, kv, vmT, a.in[6], a.in[7], a.in[10], a.in[11], a.in[5]}; pg8::gemm_phase<pg8::EpiP1, pg8::SchedP1, true, true, true>(ws, lds, DM, DM, DM, S, E);
        constexpr int NUNITS1 = pg8::P1_NUNITS;
        const int nfull = NUNITS1 % G;
        if (nfull == 0 || c >= nfull) {
            FRESH_TID();
            const int f = nfull ? c - nfull : c, nf = nfull ? G - nfull : G;
            for (int bh = f; bh < BATCH * FH; bh += nf) { elem_scan(bh, tid, lf, nck, (LAS float*)(lds + pg8::XCH_OFF)); __syncthreads(); }
            LAS unsigned* scr = (LAS unsigned*)(lds + wave * 8448);
            constexpr int I_ALL = (DM / 64) * (DFF / 64);
#define TC_DESC(r, src, ldw, K, nblk, g, dst, it) do { src = 17; ldw = DFF; K = DM; nblk = DFF / 64; g = 1; dst = WS_WUP; it = (r); } while (0)
            struct TcD { int src, ld, K, nb, g, it; size_t dst; };
            const int stride = nf * NWAVES;
            TrRegs t0, t1, t2; TcD d0{12, DM, 1024, DM / 64, 0, 0, WS_WC}, d1 = d0, d2 = d0;
            int r0 = f * NWAVES + wave, r1 = r0 + stride, r2 = r1 + stride;
            if (r0 < I_ALL) { TC_DESC(r0, d0.src, d0.ld, d0.K, d0.nb, d0.g, d0.dst, d0.it); p0_tr_load(t0, a.in[d0.src], d0.ld, d0.nb, 0, d0.it, lane); }
            if (r1 < I_ALL) { TC_DESC(r1, d1.src, d1.ld, d1.K, d1.nb, d1.g, d1.dst, d1.it); p0_tr_load(t1, a.in[d1.src], d1.ld, d1.nb, 0, d1.it, lane); }
#pragma unroll 1
            while (r0 < I_ALL) {
                if (r2 < I_ALL) { TC_DESC(r2, d2.src, d2.ld, d2.K, d2.nb, d2.g, d2.dst, d2.it); p0_tr_load(t2, a.in[d2.src], d2.ld, d2.nb, 0, d2.it, lane); }
                p0_tr_store(t0, d0.K, d0.nb, d0.g ? a.in[16] : nullptr, (bf16_t*)(ws + d0.dst), 0, scr, d0.it, lane);
                t0 = t1; d0 = d1; r0 = r1; t1 = t2; d1 = d2; r1 = r2; r2 += stride;
            }
#undef TC_DESC
        }
    }
    SEAM(1);
    if (IN(3)) {
        constexpr int Q_FOX = 256, Q_CONV = Q_FOX + 256, Q_MEM = Q_CONV + 128, Q_END = Q_MEM + 256;
        unsigned* qctr = (unsigned*)(ws + WS_CTL) + 4096;
#pragma unroll 1
        for (;;) {
            __syncthreads();
            int moff = MISC_OFF + 64; asm volatile("" : "+s"(moff));
            volatile LAS unsigned* mbox = (volatile LAS unsigned*)(lds + moff);
            if (threadIdx.x == 0) *mbox = atomicAdd(qctr, 1u);
            __syncthreads();
            const int it = __builtin_amdgcn_readfirstlane((int)*mbox);
            if (it >= Q_END) break;
            if (it < Q_FOX) fox::phase_item((FLAS char*)lds, proj, nck, a.in[6], a.in[7], it & 15, 15 - (it >> 4));
            else if (it < Q_CONV) { const int L = it - Q_FOX; pg8::Unit u; u.pm = L >> 3; u.pn = L & 7; u.seg = 0;
                u.A = (unsigned)WS_PROJ + ((unsigned)u.pm * 256 * PJ + PC_BG) * 2; u.B = (unsigned)WS_WC + (unsigned)u.pn * 256 * 1024 * 2;
                pg8::SchedOne S{u}; pg8::EpiP3 E{gates, (bf16_t*)a.out, merged}; pg8::gemm_phase(ws, lds, PJ, 1024, 1024, S, E); }
            else if (it < Q_MEM) { const int f = it - Q_CONV, b = f >> 6, hm = (f >> 4) & 3, qb = f & 15;
                { pg8::Unit u; u.pm = b * 16 + qb; u.pn = 0; u.seg = hm;
                  u.A = (unsigned)WS_PROJ + ((unsigned)u.pm * 256 * PJ + PC_MQ + hm * MD) * 2; u.B = (unsigned)WS_KV + ((unsigned)b * MT * 2048 + hm * MD) * 2;
                  pg8::SchedOne S{u}; pg8::EpiMemS E{PM}; pg8::gemm_phase(ws, lds, PJ, 2048, MD, S, E); }
                { pg8::Unit u; u.pm = b * 16 + qb; u.pn = 0; u.seg = hm;
                  u.A = (unsigned)WS_PM + ((unsigned)u.pm * 256 * 1024 + hm * MT) * 2; u.B = (unsigned)WS_VMT + (unsigned)(b * MH + hm) * MD * MT * 2;
                  pg8::SchedOne S{u}; pg8::EpiPlain E{proj + PC_MQ + hm * MD, PJ}; pg8::gemm_phase(ws, lds, 1024, MT, MT, S, E); } }
            else { FRESH_TID();
                LAS unsigned* scr = (LAS unsigned*)(lds + wave * 8448);
                const int i0 = (it - Q_MEM) * 16 + wave * 2;
                TrRegs ta, tb; p0_tr_load(ta, a.in[18], DM, DM / 64, 0, i0, lane); p0_tr_load(tb, a.in[18], DM, DM / 64, 0, i0 + 1, lane);
                p0_tr_store(ta, DFF, DM / 64, nullptr, (bf16_t*)(ws + WS_WDN), 0, scr, i0, lane); p0_tr_store(tb, DFF, DM / 64, nullptr, (bf16_t*)(ws + WS_WDN), 0, scr, i0 + 1, lane); }
        }
    }
    SEAM(3);
    if (IN(4)) { pg8::SchedP3 S{(unsigned)WS_PROJ, (unsigned)WS_WC, G, c}; pg8::EpiP3 E{gates, (bf16_t*)a.out, merged}; pg8::gemm_phase(ws, lds, PJ, 1024, 1024, S, E); }
    SEAM(4);
    if (IN(5)) { pg8::SchedG S{(unsigned)WS_MERGED, (unsigned)WS_WOUT, DM, DM, M / 256, DM / 256, G, c}; pg8::EpiP4 E{a.in[0], x1b, ssp}; pg8::gemm_phase(ws, lds, DM, DM, DM, S, E); }
    SEAM(5);
    if (IN(6)) { pg8::SchedG S{(unsigned)WS_X1B, (unsigned)WS_WUP, DM, DM, M / 256, DFF / 256, G, c}; pg8::EpiP5 E{ssp, U}; pg8::gemm_phase<pg8::EpiP5, pg8::SchedG, true, true, true>(ws, lds, DM, DM, DM, S, E); }
    SEAM(6);
    if (IN(7)) { pg8::SchedG S{(unsigned)WS_U, (unsigned)WS_WDN, DFF, DFF, M / 256, DM / 256, G, c}; pg8::EpiP6 E{a.out, x1b}; pg8::gemm_phase(ws, lds, DFF, DFF, DFF, S, E); }
#undef IN
#undef SEAM
}

#ifndef N_LAUNCHES
#define N_LAUNCHES 1
#endif
extern "C" void kernel_launch(void* const* d_in, const int* in_sizes, int n_in, void* d_out, int out_size, void* d_ws, size_t ws_size, hipStream_t stream) {
    if (n_in != 19 || in_sizes[0] != M * DM || out_size != M * DM || ws_size < WS_END) {
        fprintf(stderr, "kernel_launch: unexpected shapes (n_in %d, in0 %d, out %d, ws %zu < %zu)\n", n_in, n_in > 0 ? in_sizes[0] : -1, out_size, ws_size, (size_t)WS_END); return; }
    static bool attr = false; static int grid = 256;
    if (!attr) { attr = true;
        if (hipFuncSetAttribute((const void*)mega, hipFuncAttributeMaxDynamicSharedMemorySize, LDS_BYTES) != hipSuccess) fprintf(stderr, "kernel_launch: hipFuncSetAttribute(mega) failed\n");
        int dev = 0, cus = 0; if (hipGetDevice(&dev) == hipSuccess && hipDeviceGetAttribute(&cus, hipDeviceAttributeMultiprocessorCount, dev) == hipSuccess && cus > 0) grid = cus; }
    if (grid < pg8::P1_NTRI) { fprintf(stderr, "kernel_launch: grid %d < %d conv-branch unit triples\n", grid, pg8::P1_NTRI); return; }
    Args ka{}; for (int i = 0; i < 19; ++i) ka.in[i] = (const float*)d_in[i]; ka.out = (float*)d_out; ka.ws = (unsigned char*)d_ws;
    if (N_LAUNCHES == 1) {
        (void)hipMemsetAsync((char*)d_ws + WS_CTL, 0, 65536, stream);
        ka.ph_lo = 0; ka.ph_hi = NPH; hipLaunchKernelGGL(mega, dim3(grid), dim3(NWAVES * 64), LDS_BYTES, stream, ka);
    } else {
        for (int p = 0; p < NPH; ++p) { ka.ph_lo = p; ka.ph_hi = p + 1; hipLaunchKernelGGL(mega, dim3(grid), dim3(NWAVES * 64), LDS_BYTES, stream, ka); }
    }
}
```

```cpp
#include <hip/hip_runtime.h>
#include <hip/hip_bf16.h>
#include <cstdio>
#include <cstdint>

typedef unsigned short bf16_t;
typedef short bf16x8 __attribute__((ext_vector_type(8)));
typedef float f32x4 __attribute__((ext_vector_type(4)));
typedef float f32x16 __attribute__((ext_vector_type(16)));
typedef unsigned u32x4 __attribute__((ext_vector_type(4)));
typedef unsigned u32x2 __attribute__((ext_vector_type(2)));

constexpr int BATCH = 2, SEQ = 4096, DM = 2048, M = BATCH * SEQ;
constexpr int CW = 1024, FH = 8, FD = 128, MT = 256, MH = 4, MD = 256, DFF = 8192;
constexpr int IN_COLS = 13320, OC_FL = 6144;
constexpr int NPACK = 13312;
constexpr int PJ = 7168;
constexpr int PC_BG = 0, PC_CG = 1024, PC_V = 2048, PC_FQ = 3072, PC_FK = 4096, PC_FV = 5120, PC_MQ = 6144;
constexpr int NG = 6144;
constexpr float EPS = 1e-6f;
constexpr float LOG2E = 1.4426950408889634f;
constexpr float C2F = 0.08838834764831845f * LOG2E;
constexpr float C2M = 0.0625f * LOG2E;

constexpr size_t MiB = 1u << 20;
constexpr size_t WS_CTL = 0;
constexpr size_t WS_WIN = 1 * MiB;
constexpr size_t WS_WC = 61 * MiB;
constexpr size_t WS_WOUT = 73 * MiB;
constexpr size_t WS_WUP = 81 * MiB;
constexpr size_t WS_WDN = 113 * MiB;
constexpr size_t WS_HB = 145 * MiB;
constexpr size_t WS_PROJ = 179 * MiB;
constexpr size_t WS_GATES = 291 * MiB;
constexpr size_t WS_KV = 387 * MiB;
constexpr size_t WS_VMT = 389 * MiB;
constexpr size_t WS_PM = 390 * MiB;
constexpr size_t WS_LF = 406 * MiB;
constexpr size_t WS_NCK = WS_LF + 256 * 1024;
constexpr size_t WS_RV = WS_LF + 512 * 1024;
constexpr size_t WS_SSP = 407 * MiB;
constexpr size_t WS_END = 408 * MiB;
constexpr size_t WS_MERGED = WS_WIN;
constexpr size_t WS_U = WS_PROJ;
constexpr size_t WS_X1B = WS_HB;

__device__ __forceinline__ float bf2f(bf16_t v) { return __uint_as_float(((unsigned)v) << 16); }
__device__ __forceinline__ bf16_t f2bf(float f) { unsigned u = __float_as_uint(f); return (bf16_t)((u + 0x7fffu + ((u >> 16) & 1u)) >> 16); }
__device__ __forceinline__ unsigned pk2(float lo, float hi) { return (unsigned)f2bf(lo) | ((unsigned)f2bf(hi) << 16); }
__device__ __forceinline__ float wave_sum(float v) {
#pragma unroll
    for (int o = 1; o < 64; o <<= 1) v += __shfl_xor(v, o);
    return v;
}
__device__ __forceinline__ float wave_max(float v) {
#pragma unroll
    for (int o = 1; o < 64; o <<= 1) v = fmaxf(v, __shfl_xor(v, o));
    return v;
}
__device__ __forceinline__ void unpack8(u32x4 w, float* v) {
    v[0] = __uint_as_float(w.x << 16); v[1] = __uint_as_float(w.x & 0xffff0000u);
    v[2] = __uint_as_float(w.y << 16); v[3] = __uint_as_float(w.y & 0xffff0000u);
    v[4] = __uint_as_float(w.z << 16); v[5] = __uint_as_float(w.z & 0xffff0000u);
    v[6] = __uint_as_float(w.w << 16); v[7] = __uint_as_float(w.w & 0xffff0000u);
}
__device__ __forceinline__ u32x4 pack8f(const float* v) { u32x4 w; w.x = pk2(v[0], v[1]); w.y = pk2(v[2], v[3]); w.z = pk2(v[4], v[5]); w.w = pk2(v[6], v[7]); return w; }

__device__ __forceinline__ void elem_scan(int bh, int tid, const float* __restrict__ lf, float* __restrict__ nck, __attribute__((address_space(3))) float* xs) {
    const int b = bh >> 3, h = bh & 7, lane = tid & 63, wave = tid >> 6;
    const float* src = lf + ((size_t)b * SEQ + 8 * tid) * 8 + h;
    float v[8];
#pragma unroll
    for (int e = 0; e < 8; ++e) v[e] = src[e * 8];
    float s = 0.f;
#pragma unroll
    for (int e = 0; e < 8; ++e) { s += v[e]; v[e] = s; }
    float incl = s;
#pragma unroll
    for (int o = 1; o < 64; o <<= 1) { const float n = __shfl_up(incl, o); if (lane >= o) incl += n; }
    if (lane == 63) xs[wave] = incl;
    __syncthreads();
    float off = incl - s;
    for (int w = 0; w < wave; ++w) off += xs[w];
    f32x4 o0, o1;
#pragma unroll
    for (int e = 0; e < 4; ++e) { o0[e] = -(off + v[e]) * LOG2E; o1[e] = -(off + v[4 + e]) * LOG2E; }
    float* dst = nck + (size_t)bh * SEQ + 8 * tid;
    *(f32x4*)dst = o0; *(f32x4*)(dst + 4) = o1;
}

namespace pg8 {
#define PG8_LAS __attribute__((address_space(3)))
constexpr int BM = 256, BK = 64, HALF = 128, HTB = HALF * BK * 2, STAGE_BYTES = 8 * HTB, NXCD = 8, WGM = 4;
__host__ __device__ __forceinline__ int lds_byte(int r, int c) { const int st = (r >> 4) * 2 + (c >> 5), rr = r & 15, cc = c & 31, ob = rr * 64 + cc * 2; return st * 1024 + (ob ^ (((ob >> 9) & 1) << 5)); }
__host__ __device__ __forceinline__ void stage_rc(int b, int& R, int& C) { const int st = b / 1024, sb = b % 1024, swz = sb ^ (((sb >> 9) & 1) << 5); R = (st >> 1) * 16 + swz / 64; C = (st & 1) * 32 + (swz % 64) / 2; }
__host__ __device__ __forceinline__ int perm32(int rho) { const int n = rho >> 4, i = rho & 15; return 8 * (i >> 2) + 4 * n + (i & 3); }
struct Unit { unsigned A, B; int pm, pn, seg; };
typedef __amdgpu_buffer_rsrc_t Rsrc;
__device__ __forceinline__ void tile_of(int L, int nM, int nN, int& pm, int& pn) {
    const int nwg = nM * nN; int wgid = L;
    { const int q = nwg / NXCD, r = nwg % NXCD, xcd = wgid % NXCD, off = wgid / NXCD; wgid = (xcd < r ? xcd * (q + 1) : r * (q + 1) + (xcd - r) * q) + off; }
    const int nig = WGM * nN, gid = wgid / nig, fm = gid * WGM, gsz = (nM - fm) < WGM ? (nM - fm) : WGM;
    pm = fm + ((wgid % nig) % gsz); pn = (wgid % nig) / gsz;
}
__device__ __forceinline__ unsigned cvt_pk_bf16(float lo, float hi) { unsigned r; asm volatile("v_cvt_pk_bf16_f32 %0, %1, %2" : "=v"(r) : "v"(lo), "v"(hi)); return r; }
template <class Epi, class Sched, bool ALIGN_EPI = true, bool SP2 = true, bool PEEL = false>
__device__ __forceinline__ void gemm_phase(unsigned char* wsb, PG8_LAS unsigned char* lds, const int lda, const int ldb, const int K, const Sched& S, const Epi& E) {
    int tid_ = threadIdx.x; asm volatile("" : "+v"(tid_));
    asm volatile("" : "+s"(wsb));
    const Rsrc rs = __builtin_amdgcn_make_buffer_rsrc((void*)wsb, 0, -1, 0x00020000);
    const int tid = tid_, wid = __builtin_amdgcn_readfirstlane(tid >> 6), lane = tid & 63, wr = wid >> 2, wc = wid & 3, fr = lane & 15, fq = lane >> 4;
    const int nt = K / BK;
    unsigned voffA[2], voffB[2];
#pragma unroll
    for (int i = 0; i < 2; ++i) { int R, C; stage_rc(tid * 16 + i * 8192, R, C); const int Rb = (R & ~31) + perm32(R & 31);
        voffA[i] = (unsigned)(R * lda + C) * 2u; voffB[i] = (unsigned)(Rb * ldb + C) * 2u; }
    const unsigned kstep = (unsigned)(BK * 2);
    const unsigned hstepA = (unsigned)HALF * lda * 2, hstepB = (unsigned)HALF * ldb * 2;
    const unsigned ldsw = (unsigned)wid * 1024u;
    const int aoff = lds_byte(wr * 64 + fr, fq * 8), boff = lds_byte(wc * 32 + fr, fq * 8);
#define PG8_SA(b, h) (((b) * 2 + (h)) * HTB)
#define PG8_SB(b, h) ((4 + (b) * 2 + (h)) * HTB)
#define PG8_STAGE(bufoff, soff, voff) do { _Pragma("unroll") for (int _i = 0; _i < 2; ++_i) \
        __builtin_amdgcn_raw_ptr_buffer_load_lds(rs, (PG8_LAS void*)(lds + (bufoff) + ldsw + _i * 8192), 16, (int)(voff)[_i], (int)(soff), 0, 0); } while (0)
#define PG8_LDA(dst, b, h) do { _Pragma("unroll") for (int m = 0; m < 4; ++m) _Pragma("unroll") for (int k = 0; k < 2; ++k) dst[m][k] = *(const PG8_LAS bf16x8*)(lds + PG8_SA(b, h) + aoff + m * 2048 + k * 1024); } while (0)
#define PG8_LDB(dst, b, h) do { _Pragma("unroll") for (int n = 0; n < 2; ++n) _Pragma("unroll") for (int k = 0; k < 2; ++k) dst[n][k] = *(const PG8_LAS bf16x8*)(lds + PG8_SB(b, h) + boff + n * 2048 + k * 1024); } while (0)
#define PG8_MMA(ai, bj, At, Bt) do { __builtin_amdgcn_s_setprio(1); _Pragma("unroll") for (int m = 0; m < 4; ++m) _Pragma("unroll") for (int n = 0; n < 2; ++n) _Pragma("unroll") for (int k = 0; k < 2; ++k) \
        acc[ai][bj][m][n] = __builtin_amdgcn_mfma_f32_16x16x32_bf16(Bt[n][k], At[m][k], acc[ai][bj][m][n], 0, 0, 0); __builtin_amdgcn_s_setprio(0); } while (0)
#define PG8_WAIT_V(n) asm volatile("s_waitcnt vmcnt(" #n ")" ::: "memory")
#define PG8_WAIT_L(n) asm volatile("s_waitcnt lgkmcnt(" #n ")" ::: "memory")
#define PG8_BAR __builtin_amdgcn_s_barrier()
#define PG8_SCHED __builtin_amdgcn_sched_barrier(0)
    Unit cur, nxt; int ui = 0;
    if (!S.next(0, cur)) return;
    f32x4 acc[2][2][4][2];
#pragma unroll
    for (int a = 0; a < 2; ++a)
#pragma unroll
        for (int b = 0; b < 2; ++b)
#pragma unroll
            for (int m = 0; m < 4; ++m)
#pragma unroll
                for (int n = 0; n < 2; ++n) acc[a][b][m][n] = (f32x4){0.f, 0.f, 0.f, 0.f};
    bf16x8 At[4][2], B0[2][2], B1[2][2];
    unsigned cA = cur.A, cB = cur.B;
    if constexpr (SP2) {
        PG8_STAGE(PG8_SB(0, 0), cB, voffB); PG8_STAGE(PG8_SB(0, 1), cB + hstepB, voffB); PG8_STAGE(PG8_SA(0, 0), cA, voffA); PG8_STAGE(PG8_SA(0, 1), cA + hstepA, voffA);
        PG8_STAGE(PG8_SB(1, 0), cB + kstep, voffB); PG8_STAGE(PG8_SA(1, 0), cA + kstep, voffA); PG8_STAGE(PG8_SB(1, 1), cB + hstepB + kstep, voffB);
        if (wr == 1) PG8_BAR;
        PG8_WAIT_V(8); PG8_BAR;
        PG8_WAIT_V(6); PG8_BAR;
    } else {
        PG8_STAGE(PG8_SB(0, 0), cB, voffB); PG8_STAGE(PG8_SA(0, 0), cA, voffA); PG8_STAGE(PG8_SB(0, 1), cB + hstepB, voffB); PG8_STAGE(PG8_SA(0, 1), cA + hstepA, voffA);
        if (wr == 1) PG8_BAR;
        PG8_WAIT_V(4); PG8_BAR;
        PG8_STAGE(PG8_SB(1, 0), cB + kstep, voffB); PG8_STAGE(PG8_SA(1, 0), cA + kstep, voffA); PG8_STAGE(PG8_SB(1, 1), cB + hstepB + kstep, voffB);
        PG8_WAIT_V(6); PG8_BAR;
    }
    for (;;) {
        const bool has_next = S.next(ui + 1, nxt);
        const unsigned nA = has_next ? nxt.A : cA, nB = has_next ? nxt.B : cB;
#define PG8_TRIP(t, W) do { \
            const bool last = ((t) == nt - 2); \
            const unsigned a1 = cA + (unsigned)((t) + 1) * kstep; \
            const unsigned a2 = last ? nA : cA + (unsigned)((t) + 2) * kstep, b2 = last ? nB : cB + (unsigned)((t) + 2) * kstep; \
            const unsigned a3 = a2 + kstep, b3 = b2 + kstep; \
            PG8_LDB(B0, 0, 0); PG8_LDB(B1, 0, 1); PG8_SCHED; PG8_LDA(At, 0, 0); PG8_STAGE(PG8_SA(1, 1), a1 + hstepA, voffA); \
            PG8_WAIT_V(W); PG8_WAIT_L(0); PG8_BAR; PG8_MMA(0, 0, At, B0); PG8_MMA(0, 1, At, B1); PG8_BAR; PG8_SCHED; \
            PG8_LDA(At, 0, 1); PG8_STAGE(PG8_SB(0, 0), b2, voffB); PG8_STAGE(PG8_SB(0, 1), b2 + hstepB, voffB); PG8_STAGE(PG8_SA(0, 0), a2, voffA); \
            PG8_WAIT_V(W); PG8_WAIT_L(0); PG8_BAR; PG8_MMA(1, 0, At, B0); PG8_MMA(1, 1, At, B1); PG8_BAR; PG8_SCHED; \
            PG8_LDB(B0, 1, 0); PG8_LDB(B1, 1, 1); PG8_SCHED; PG8_LDA(At, 1, 0); PG8_STAGE(PG8_SA(0, 1), a2 + hstepA, voffA); \
            PG8_WAIT_V(8); PG8_WAIT_L(0); PG8_BAR; PG8_MMA(0, 0, At, B0); PG8_MMA(0, 1, At, B1); PG8_BAR; PG8_SCHED; \
            PG8_LDA(At, 1, 1); PG8_STAGE(PG8_SB(1, 0), b3, voffB); PG8_STAGE(PG8_SB(1, 1), b3 + hstepB, voffB); PG8_STAGE(PG8_SA(1, 0), a3, voffA); \
            PG8_WAIT_V(8); PG8_WAIT_L(0); PG8_BAR; PG8_MMA(1, 0, At, B0); PG8_MMA(1, 1, At, B1); PG8_BAR; PG8_SCHED; } while (0)
        static_assert(SP2, "this build keeps only the two-MFMA-blocks-per-barrier-pair schedule");
        int t0 = 0;
        if constexpr (PEEL) { if (ui > 0) { PG8_TRIP(0, 24); t0 = 2; } }
        for (int t = t0; t < nt; t += 2) PG8_TRIP(t, 8);
#undef PG8_TRIP
        if constexpr (ALIGN_EPI) { if (wr == 0) PG8_BAR; }
        E(acc, cur, wr, wc, fr, fq, lds);
        if (!has_next) break;
#pragma unroll
        for (int a = 0; a < 2; ++a)
#pragma unroll
            for (int b = 0; b < 2; ++b)
#pragma unroll
                for (int m = 0; m < 4; ++m)
#pragma unroll
                    for (int n = 0; n < 2; ++n) acc[a][b][m][n] = (f32x4){0.f, 0.f, 0.f, 0.f};
        cur = nxt; cA = nA; cB = nB; ++ui;
        if constexpr (ALIGN_EPI) { if (wr == 1) PG8_BAR; }
    }
    PG8_WAIT_V(0);
    if constexpr (!ALIGN_EPI) { if (wr == 0) PG8_BAR; }
    PG8_BAR;
#undef PG8_SA
#undef PG8_SB
#undef PG8_STAGE
#undef PG8_LDA
#undef PG8_LDB
#undef PG8_MMA
#undef PG8_WAIT_V
#undef PG8_WAIT_L
#undef PG8_BAR
#undef PG8_SCHED
}
typedef f32x4 Acc[2][2][4][2];
constexpr int XCH_OFF = 131072 + 1024;

struct EpiP1 { bf16_t* proj; bf16_t* gates; bf16_t* kv; bf16_t* vmT; const float* fqg; const float* fkg; const float* mqg; const float* mkg; const float* conv_w;
    __device__ __forceinline__ void operator()(Acc& acc, const Unit& u, int wr, int wc, int fr, int fq, PG8_LAS unsigned char* lds) const {
        asm volatile("" : "+v"(fr), "+v"(fq));
        bf16_t* base; int ldc; int kind = 0; int colt = u.pn * BM;
        if (u.seg == 1) { base = kv; ldc = 2048; kind = 3; }
        else if (u.seg == 2) { base = vmT + (size_t)u.pn * (MD * MT); ldc = MT; colt = 0; }
        else if (u.pn < PJ / BM) { base = proj; ldc = PJ; kind = u.seg >= 4 ? u.seg : ((u.pn >= PC_FQ / BM && u.pn < PC_FV / BM) ? 2 : (u.pn >= PC_MQ / BM ? 3 : 0)); }
        else { base = gates; ldc = NG; colt -= PJ; kind = 1; }
        const int row0 = u.pm + wr * 64 + fr, col0 = colt + wc * 32 + 8 * fq;
        if (kind == 4) {
#pragma unroll
            for (int ai = 0; ai < 2; ++ai) { u32x4 Cq[4][2];
#pragma unroll
                for (int m = 0; m < 4; ++m)
#pragma unroll
                    for (int bj = 0; bj < 2; ++bj) Cq[m][bj] = *(const u32x4*)((const char*)base + (unsigned)((row0 + ai * HALF + m * 16) * PJ + col0 + bj * HALF - (PC_V - PC_CG)) * 2u);
#pragma unroll
                for (int m = 0; m < 4; ++m)
#pragma unroll
                    for (int bj = 0; bj < 2; ++bj) { float g[8]; unpack8(Cq[m][bj], g);
                        f32x4 v0 = acc[ai][bj][m][0], v1 = acc[ai][bj][m][1];
#pragma unroll
                        for (int e = 0; e < 4; ++e) { v0[e] *= g[e]; v1[e] *= g[4 + e]; }
                        u32x4 w; w.x = cvt_pk_bf16(v0[0], v0[1]); w.y = cvt_pk_bf16(v0[2], v0[3]); w.z = cvt_pk_bf16(v1[0], v1[1]); w.w = cvt_pk_bf16(v1[2], v1[3]);
                        *(u32x4*)((char*)base + (unsigned)((row0 + ai * HALF + m * 16) * PJ + col0 + bj * HALF) * 2u) = w; }
                asm volatile("" ::: "memory"); }
            return;
        }
        if (kind == 5) {
            const bool first = (u.pm & (SEQ - 1)) == 0;
#pragma unroll
            for (int bj = 0; bj < 2; ++bj) { const int ch = col0 + bj * HALF;
                const f32x4 k0a = *(const f32x4*)(conv_w + ch), k0b = *(const f32x4*)(conv_w + ch + 4), k1a = *(const f32x4*)(conv_w + CW + ch), k1b = *(const f32x4*)(conv_w + CW + ch + 4),
                            k2a = *(const f32x4*)(conv_w + 2 * CW + ch), k2b = *(const f32x4*)(conv_w + 2 * CW + ch + 4);
#pragma unroll
                for (int ai = 0; ai < 2; ++ai) { u32x4 Uq[4][3];
#pragma unroll
                    for (int m = 0; m < 4; ++m) { const int row = row0 + ai * HALF + m * 16; const unsigned o0 = (unsigned)(row * PJ + PC_V + ch) * 2u;
                        Uq[m][0] = *(const u32x4*)((const char*)base + o0); Uq[m][1] = *(const u32x4*)((const char*)base + (row >= 1 ? o0 - 2u * PJ : o0)); Uq[m][2] = *(const u32x4*)((const char*)base + (row >= 2 ? o0 - 4u * PJ : o0)); }
#pragma unroll
                    for (int m = 0; m < 4; ++m) { const int row = row0 + ai * HALF + m * 16, t = row & (SEQ - 1), lr = ai * HALF + wr * 64 + m * 16 + fr;
                        const u32x4 Z = {0u, 0u, 0u, 0u};
                        float a0[8], a1[8], a2[8]; unpack8(Uq[m][0], a0); unpack8(t >= 1 ? Uq[m][1] : Z, a1); unpack8(t >= 2 ? Uq[m][2] : Z, a2);
                        f32x4 v0 = acc[ai][bj][m][0], v1 = acc[ai][bj][m][1];
#pragma unroll
                        for (int e = 0; e < 4; ++e) { v0[e] *= k2a[e] * a0[e] + k1a[e] * a1[e] + k0a[e] * a2[e]; v1[e] *= k2b[e] * a0[4 + e] + k1b[e] * a1[4 + e] + k0b[e] * a2[4 + e]; }
                        u32x4 w; w.x = cvt_pk_bf16(v0[0], v0[1]); w.y = cvt_pk_bf16(v0[2], v0[3]); w.z = cvt_pk_bf16(v1[0], v1[1]); w.w = cvt_pk_bf16(v1[2], v1[3]);
                        if (first || lr >= 2) *(u32x4*)((char*)base + (unsigned)(row * PJ + ch) * 2u) = w; }
                    asm volatile("" ::: "memory"); } }
            return;
        }
        if (kind >= 2) {
            PG8_LAS float* X = (PG8_LAS float*)(lds + XCH_OFF);
#pragma unroll
            for (int ai = 0; ai < 2; ++ai)
#pragma unroll
                for (int m = 0; m < 4; ++m)
#pragma unroll
                    for (int bj = 0; bj < 2; ++bj) { const f32x4 v0 = acc[ai][bj][m][0], v1 = acc[ai][bj][m][1];
                        float s = (v0[0] * v0[0] + v0[1] * v0[1]) + (v0[2] * v0[2] + v0[3] * v0[3]) + (v1[0] * v1[0] + v1[1] * v1[1]) + (v1[2] * v1[2] + v1[3] * v1[3]);
                        s += __shfl_xor(s, 16); s += __shfl_xor(s, 32);
                        if (fq == 0) X[((ai * HALF + wr * 64 + m * 16 + fr) * 2 + bj) * 4 + wc] = s; }
            asm volatile("s_waitcnt lgkmcnt(0)" ::: "memory"); __builtin_amdgcn_s_barrier(); asm volatile("" ::: "memory");
            const bool isq = u.pn < PC_FK / BM;
            const float inv = kind == 3 ? (1.f / MD) : (1.f / FD);
            f32x4 g[2][2];
            if (kind == 3) { const float* gp = u.seg == 1 ? mkg : mqg; const float sc = u.seg == 1 ? 1.f : C2M;
#pragma unroll
                for (int bj = 0; bj < 2; ++bj) { const int gi = bj * HALF + wc * 32 + 8 * fq; g[bj][0] = *(const f32x4*)(gp + gi) * sc; g[bj][1] = *(const f32x4*)(gp + gi + 4) * sc; }
            } else if (isq) {
                const int gi = wc * 32 + 8 * fq; g[0][0] = *(const f32x4*)(fqg + gi) * C2F; g[0][1] = *(const f32x4*)(fqg + gi + 4) * C2F; g[1][0] = g[0][0]; g[1][1] = g[0][1];
            } else {
                const int gi = wc * 32 + 8 * fq; g[0][0] = *(const f32x4*)(fkg + gi); g[0][1] = *(const f32x4*)(fkg + gi + 4); g[1][0] = g[0][0]; g[1][1] = g[0][1];
            }
#pragma unroll
            for (int ai = 0; ai < 2; ++ai)
#pragma unroll
                for (int m = 0; m < 4; ++m) { const int rl = ai * HALF + wr * 64 + m * 16 + fr;
                    const f32x4 t0 = *(PG8_LAS const f32x4*)(X + rl * 8), t1 = *(PG8_LAS const f32x4*)(X + rl * 8 + 4);
                    float s0 = (t0[0] + t0[1]) + (t0[2] + t0[3]), s1 = (t1[0] + t1[1]) + (t1[2] + t1[3]);
                    if (kind == 3) { s0 += s1; s1 = s0; }
                    const float r0 = rsqrtf(s0 * inv + EPS), r1 = rsqrtf(s1 * inv + EPS);
                    bf16_t* rowp = base + (size_t)(row0 + ai * HALF + m * 16) * ldc + col0;
#pragma unroll
                    for (int bj = 0; bj < 2; ++bj) { const float r = bj ? r1 : r0; const f32x4 v0 = acc[ai][bj][m][0] * g[bj][0] * r, v1 = acc[ai][bj][m][1] * g[bj][1] * r;
                        u32x4 w; w.x = cvt_pk_bf16(v0[0], v0[1]); w.y = cvt_pk_bf16(v0[2], v0[3]); w.z = cvt_pk_bf16(v1[0], v1[1]); w.w = cvt_pk_bf16(v1[2], v1[3]);
                        *(u32x4*)(rowp + bj * HALF) = w; } }
            return;
        }
        const bool sig = kind == 1;
#pragma unroll
        for (int ai = 0; ai < 2; ++ai)
#pragma unroll
            for (int m = 0; m < 4; ++m) { bf16_t* rowp = base + (size_t)(row0 + ai * HALF + m * 16) * ldc + col0;
#pragma unroll
                for (int bj = 0; bj < 2; ++bj) { f32x4 v0 = acc[ai][bj][m][0], v1 = acc[ai][bj][m][1];
                    if (sig) {
#pragma unroll
                        for (int e = 0; e < 4; ++e) { v0[e] = __builtin_amdgcn_rcpf(1.f + __builtin_amdgcn_exp2f(-LOG2E * v0[e])); v1[e] = __builtin_amdgcn_rcpf(1.f + __builtin_amdgcn_exp2f(-LOG2E * v1[e])); } }
                    u32x4 w; w.x = cvt_pk_bf16(v0[0], v0[1]); w.y = cvt_pk_bf16(v0[2], v0[3]); w.z = cvt_pk_bf16(v1[0], v1[1]); w.w = cvt_pk_bf16(v1[2], v1[3]);
                    *(u32x4*)(rowp + bj * HALF) = w; } }
    } };
constexpr int P1_NTRI = BATCH * 17 * 4, P1_NPOOL = (M / BM) * ((NPACK - 3 * CW) / BM) + 16, P1_NUNITS = 3 * P1_NTRI + P1_NPOOL;
struct SchedP1 { unsigned hb, W; int G, c;
    __device__ __forceinline__ bool next(int i, Unit& u) const {
        constexpr int nM = M / BM, nN = (NPACK - 3 * CW) / BM, NMAIN = nM * nN;
        int p;
        if (i < 3) {
            if (c < P1_NTRI) { const int j = c & 3, q = c >> 2, b = q / 17, ti = q - 17 * b;
                u.pm = b * SEQ + (ti < 16 ? 254 * ti : SEQ - BM); u.pn = (i == 0 ? 4 : (i == 1 ? 8 : 0)) + j; u.seg = i == 0 ? 0 : 3 + i;
                u.A = hb + (unsigned)u.pm * DM * 2; u.B = W + (unsigned)u.pn * BM * DM * 2; return true; }
            p = i * (G - P1_NTRI) + (c - P1_NTRI);
        } else p = 3 * (G - P1_NTRI) + (i - 3) * G + c;
        if (p >= 16 + NMAIN) return false;
        if (p >= 16) { int pm, pn; tile_of(p - 16, nM, nN, pm, pn); u.pm = pm * BM; u.pn = pn + 3 * CW / BM; u.seg = 0; u.A = hb + (unsigned)u.pm * DM * 2; u.B = W + (unsigned)u.pn * BM * DM * 2; return true; }
        const int r = p;
        const int b = r >> 3, hm = r & 3;
        if ((r & 4) == 0) { u.seg = 1; u.pm = b * MT; u.pn = hm; u.A = hb + (unsigned)(M + b * MT) * DM * 2; u.B = W + (unsigned)(NPACK + hm * MD) * DM * 2; }
        else { u.seg = 2; u.pm = 0; u.pn = b * MH + hm; u.A = W + (unsigned)(NPACK + MH * MD + hm * MD) * DM * 2; u.B = hb + (unsigned)(M + b * MT) * DM * 2; }
        return true; } };

struct EpiP3 { const bf16_t* gates; bf16_t* tmp; bf16_t* merged;
    __device__ __forceinline__ void operator()(Acc& acc, const Unit& u, int wr, int wc, int fr, int fq, PG8_LAS unsigned char*) const {
        asm volatile("" : "+v"(fr), "+v"(fq));
        const int row0 = u.pm * BM + wr * 64 + fr, col0 = u.pn * BM + wc * 32 + 8 * fq;
#pragma unroll
        for (int ai = 0; ai < 2; ++ai) { u32x4 Gq[4][2], Tq[4][2];
#pragma unroll
            for (int m = 0; m < 4; ++m)
#pragma unroll
                for (int bj = 0; bj < 2; ++bj) { const size_t row = (size_t)(row0 + ai * HALF + m * 16); const int col = col0 + bj * HALF;
                    Gq[m][bj] = *(const u32x4*)(gates + row * NG + u.seg * DM + col); if (u.seg > 0) Tq[m][bj] = *(const u32x4*)(tmp + row * DM + col); }
#pragma unroll
            for (int m = 0; m < 4; ++m)
#pragma unroll
                for (int bj = 0; bj < 2; ++bj) { const size_t row = (size_t)(row0 + ai * HALF + m * 16); const int col = col0 + bj * HALF;
                    float g[8]; unpack8(Gq[m][bj], g);
                    f32x4 v0 = acc[ai][bj][m][0], v1 = acc[ai][bj][m][1];
#pragma unroll
                    for (int e = 0; e < 4; ++e) { v0[e] *= g[e]; v1[e] *= g[4 + e]; }
                    if (u.seg > 0) { float t[8]; unpack8(Tq[m][bj], t);
#pragma unroll
                        for (int e = 0; e < 4; ++e) { v0[e] += t[e]; v1[e] += t[4 + e]; } }
                    u32x4 w; w.x = cvt_pk_bf16(v0[0], v0[1]); w.y = cvt_pk_bf16(v0[2], v0[3]); w.z = cvt_pk_bf16(v1[0], v1[1]); w.w = cvt_pk_bf16(v1[2], v1[3]);
                    if (u.seg < 2) *(u32x4*)(tmp + row * DM + col) = w; else *(u32x4*)(merged + row * DM + col) = w; }
            asm volatile("" ::: "memory"); }
    } };
struct SchedP3 { unsigned proj, Wc; int G, c;
    __device__ __forceinline__ bool next(int i, Unit& u) const {
        const int ti = i / 2, seg = 1 + (i - 2 * ti), L = ti * G + c; constexpr int nM = M / BM, nN = DM / BM;
        if (L >= nM * nN) return false;
        tile_of(L, nM, nN, u.pm, u.pn); u.seg = seg;
        const int acol = seg == 0 ? PC_BG : (seg == 1 ? PC_FQ : PC_MQ);
        u.A = proj + ((unsigned)u.pm * BM * PJ + acol) * 2; u.B = Wc + ((unsigned)seg * DM * 1024 + (unsigned)u.pn * BM * 1024) * 2; return true; } };

struct SchedG { unsigned A, B; int lda, ldb, nM, nN, G, c;
    __device__ __forceinline__ bool next(int i, Unit& u) const {
        const int L = i * G + c; if (L >= nM * nN) return false;
        tile_of(L, nM, nN, u.pm, u.pn); u.seg = 0; u.A = A + (unsigned)u.pm * BM * lda * 2; u.B = B + (unsigned)u.pn * BM * ldb * 2; return true; } };

struct EpiP4 { const float* rv; bf16_t* x1b; float* ssp;
    __device__ __forceinline__ void operator()(Acc& acc, const Unit& u, int wr, int wc, int fr, int fq, PG8_LAS unsigned char*) const {
        asm volatile("" : "+v"(fr), "+v"(fq));
        const int row0 = u.pm * BM + wr * 64 + fr, col0 = u.pn * BM + wc * 32 + 8 * fq;
#pragma unroll
        for (int ai = 0; ai < 2; ++ai) { u32x4 Hq[4][2]; float rr[4];
#pragma unroll
            for (int m = 0; m < 4; ++m) { const size_t row = (size_t)(row0 + ai * HALF + m * 16); rr[m] = rv[row];
#pragma unroll
                for (int bj = 0; bj < 2; ++bj) Hq[m][bj] = *(const u32x4*)(x1b + row * DM + col0 + bj * HALF); }
#pragma unroll
            for (int m = 0; m < 4; ++m) { const size_t row = (size_t)(row0 + ai * HALF + m * 16); float s = 0.f;
#pragma unroll
                for (int bj = 0; bj < 2; ++bj) { float h[8]; unpack8(Hq[m][bj], h);
                    f32x4 v0 = acc[ai][bj][m][0], v1 = acc[ai][bj][m][1];
#pragma unroll
                    for (int e = 0; e < 4; ++e) { v0[e] += h[e] * rr[m]; v1[e] += h[4 + e] * rr[m]; }
                    u32x4 w; w.x = cvt_pk_bf16(v0[0], v0[1]); w.y = cvt_pk_bf16(v0[2], v0[3]); w.z = cvt_pk_bf16(v1[0], v1[1]); w.w = cvt_pk_bf16(v1[2], v1[3]);
                    *(u32x4*)(x1b + row * DM + col0 + bj * HALF) = w;
                    s += (v0[0] * v0[0] + v0[1] * v0[1]) + (v0[2] * v0[2] + v0[3] * v0[3]) + (v1[0] * v1[0] + v1[1] * v1[1]) + (v1[2] * v1[2] + v1[3] * v1[3]); }
                s += __shfl_xor(s, 16); s += __shfl_xor(s, 32);
                if (fq == 0) ssp[row * 32 + u.pn * 4 + wc] = s; }
            asm volatile("" ::: "memory"); }
    } };
struct EpiP5 { const float* ssp; bf16_t* U;
    __device__ __forceinline__ void operator()(Acc& acc, const Unit& u, int wr, int wc, int fr, int fq, PG8_LAS unsigned char*) const {
        const int row0 = u.pm * BM + wr * 64 + fr, col0 = u.pn * BM + wc * 32 + 8 * fq;
#pragma unroll
        for (int ai = 0; ai < 2; ++ai)
#pragma unroll
            for (int m = 0; m < 4; ++m) { const size_t row = (size_t)(row0 + ai * HALF + m * 16);
                const f32x4 p0 = *(const f32x4*)(ssp + row * 32 + fq * 8), p1 = *(const f32x4*)(ssp + row * 32 + fq * 8 + 4);
                float s = (p0[0] + p0[1]) + (p0[2] + p0[3]) + (p1[0] + p1[1]) + (p1[2] + p1[3]);
                s += __shfl_xor(s, 16); s += __shfl_xor(s, 32);
                const float r = rsqrtf(s * (1.f / DM) + EPS);
#pragma unroll
                for (int bj = 0; bj < 2; ++bj) { f32x4 v0 = acc[ai][bj][m][0] * r, v1 = acc[ai][bj][m][1] * r;
#pragma unroll
                    for (int e = 0; e < 4; ++e) { v0[e] = fmaxf(v0[e], 0.f); v0[e] *= v0[e]; v1[e] = fmaxf(v1[e], 0.f); v1[e] *= v1[e]; }
                    u32x4 w; w.x = cvt_pk_bf16(v0[0], v0[1]); w.y = cvt_pk_bf16(v0[2], v0[3]); w.z = cvt_pk_bf16(v1[0], v1[1]); w.w = cvt_pk_bf16(v1[2], v1[3]);
                    *(u32x4*)(U + row * DFF + col0 + bj * HALF) = w; } }
    } };
struct EpiP6 { float* out; const bf16_t* x1b;
    __device__ __forceinline__ void operator()(Acc& acc, const Unit& u, int wr, int wc, int fr, int fq, PG8_LAS unsigned char*) const {
        asm volatile("" : "+v"(fr), "+v"(fq));
        const int row0 = u.pm * BM + wr * 64 + fr, col0 = u.pn * BM + wc * 32 + 8 * fq;
#pragma unroll
        for (int ai = 0; ai < 2; ++ai) { u32x4 Tq[4][2];
#pragma unroll
            for (int m = 0; m < 4; ++m)
#pragma unroll
                for (int bj = 0; bj < 2; ++bj) Tq[m][bj] = *(const u32x4*)(x1b + (size_t)(row0 + ai * HALF + m * 16) * DM + col0 + bj * HALF);
#pragma unroll
            for (int m = 0; m < 4; ++m)
#pragma unroll
                for (int bj = 0; bj < 2; ++bj) { const size_t off = (size_t)(row0 + ai * HALF + m * 16) * DM + col0 + bj * HALF;
                    float t[8]; unpack8(Tq[m][bj], t);
                    f32x4 v0 = acc[ai][bj][m][0], v1 = acc[ai][bj][m][1];
#pragma unroll
                    for (int e = 0; e < 4; ++e) { v0[e] += t[e]; v1[e] += t[4 + e]; }
                    *(f32x4*)(out + off) = v0; *(f32x4*)(out + off + 4) = v1; }
            asm volatile("" ::: "memory"); }
    } };
struct EpiMemS { bf16_t* PM;
    __device__ __forceinline__ void operator()(Acc& acc, const Unit& u, int wr, int wc, int fr, int fq, PG8_LAS unsigned char* lds) const {
        PG8_LAS float* X1 = (PG8_LAS float*)(lds + XCH_OFF); PG8_LAS float* X2 = X1 + 1024;
#pragma unroll
        for (int ai = 0; ai < 2; ++ai)
#pragma unroll
            for (int m = 0; m < 4; ++m) { float v = -INFINITY;
#pragma unroll
                for (int bj = 0; bj < 2; ++bj)
#pragma unroll
                    for (int n = 0; n < 2; ++n)
#pragma unroll
                        for (int e = 0; e < 4; ++e) v = fmaxf(v, acc[ai][bj][m][n][e]);
                v = fmaxf(v, __shfl_xor(v, 16)); v = fmaxf(v, __shfl_xor(v, 32));
                if (fq == 0) X1[(ai * HALF + wr * 64 + m * 16 + fr) * 4 + wc] = v; }
        asm volatile("s_waitcnt lgkmcnt(0)" ::: "memory"); __builtin_amdgcn_s_barrier(); asm volatile("" ::: "memory");
#pragma unroll
        for (int ai = 0; ai < 2; ++ai)
#pragma unroll
            for (int m = 0; m < 4; ++m) { const int rl = ai * HALF + wr * 64 + m * 16 + fr;
                const f32x4 t = *(PG8_LAS const f32x4*)(X1 + rl * 4); const float mx = fmaxf(fmaxf(t[0], t[1]), fmaxf(t[2], t[3]));
                float s = 0.f;
#pragma unroll
                for (int bj = 0; bj < 2; ++bj)
#pragma unroll
                    for (int n = 0; n < 2; ++n)
#pragma unroll
                        for (int e = 0; e < 4; ++e) { const float p = __builtin_amdgcn_exp2f(acc[ai][bj][m][n][e] - mx); acc[ai][bj][m][n][e] = p; s += p; }
                s += __shfl_xor(s, 16); s += __shfl_xor(s, 32);
                if (fq == 0) X2[rl * 4 + wc] = s; }
        asm volatile("s_waitcnt lgkmcnt(0)" ::: "memory"); __builtin_amdgcn_s_barrier(); asm volatile("" ::: "memory");
        const int row0 = u.pm * BM, col0 = u.seg * MT + wc * 32 + 8 * fq;
#pragma unroll
        for (int ai = 0; ai < 2; ++ai)
#pragma unroll
            for (int m = 0; m < 4; ++m) { const int rl = ai * HALF + wr * 64 + m * 16 + fr;
                const f32x4 t = *(PG8_LAS const f32x4*)(X2 + rl * 4); const float r = 1.f / ((t[0] + t[1]) + (t[2] + t[3]));
#pragma unroll
                for (int bj = 0; bj < 2; ++bj) { const f32x4 v0 = acc[ai][bj][m][0] * r, v1 = acc[ai][bj][m][1] * r;
                    u32x4 w; w.x = cvt_pk_bf16(v0[0], v0[1]); w.y = cvt_pk_bf16(v0[2], v0[3]); w.z = cvt_pk_bf16(v1[0], v1[1]); w.w = cvt_pk_bf16(v1[2], v1[3]);
                    *(u32x4*)(PM + (size_t)(row0 + rl) * 1024 + col0 + bj * HALF) = w; } }
    } };
struct EpiPlain { bf16_t* base; int ldc;
    __device__ __forceinline__ void operator()(Acc& acc, const Unit& u, int wr, int wc, int fr, int fq, PG8_LAS unsigned char*) const {
        const int row0 = u.pm * BM + wr * 64 + fr, col0 = u.pn * BM + wc * 32 + 8 * fq;
#pragma unroll
        for (int ai = 0; ai < 2; ++ai)
#pragma unroll
            for (int m = 0; m < 4; ++m) { bf16_t* rowp = base + (size_t)(row0 + ai * HALF + m * 16) * ldc + col0;
#pragma unroll
                for (int bj = 0; bj < 2; ++bj) { const f32x4 v0 = acc[ai][bj][m][0], v1 = acc[ai][bj][m][1];
                    u32x4 w; w.x = cvt_pk_bf16(v0[0], v0[1]); w.y = cvt_pk_bf16(v0[2], v0[3]); w.z = cvt_pk_bf16(v1[0], v1[1]); w.w = cvt_pk_bf16(v1[2], v1[3]);
                    *(u32x4*)(rowp + bj * HALF) = w; } }
    } };
struct SchedOne { Unit u; __device__ __forceinline__ bool next(int i, Unit& o) const { if (i) return false; o = u; return true; } };
}


namespace fox {
#define FLAS __attribute__((address_space(3)))
constexpr int NW = 8, QBLK = 32, KVBLK = 64, QB = NW * QBLK, D = 128;
constexpr int SHM_V = KVBLK * D * 2, SHM_K = KVBLK * D * 2;
constexpr int OFF_V = 0, OFF_K = 2 * SHM_V, OFF_WS = OFF_K + 2 * SHM_K, OFF_C = OFF_WS + NW * 64 * 4, LDS_NEED = OFF_C + SEQ * 4;
constexpr float THR2 = 8.f * LOG2E;
#define KSWZ(row, colB) ((row) * 256 + ((colB) ^ (((row) & 7) << 4)))
#define SBAR() __builtin_amdgcn_sched_barrier(0)
__device__ __forceinline__ int v_st(int k, int c) { const int kk = (k & ~0xC) | ((k & 4) << 1) | ((k & 8) >> 1); return ((kk >> 3) * 4 + (c >> 5)) * 512 + ((kk & 7) * 32 + (c & 31)) * 2; }
__device__ __forceinline__ int v_rd_base(int lane) { return ((lane & 3) << 3) | (((lane >> 2) & 3) << 6) | (((lane >> 4) & 1) << 5) | (((lane >> 5) & 1) << 8); }
constexpr int v_rd_off(int d0, int ks, int half) { return d0 * 512 + ks * 4096 + half * 2048; }
__device__ __forceinline__ int crow(int r, int hi) { return (r & 3) + 8 * (r >> 2) + 4 * hi; }
__device__ __forceinline__ unsigned cvtpk(float lo, float hi) { unsigned r; asm volatile("v_cvt_pk_bf16_f32 %0, %1, %2" : "=v"(r) : "v"(lo), "v"(hi)); return r; }
typedef short s16x4 __attribute__((ext_vector_type(4)));
__device__ __forceinline__ void mask_tile(f32x16& p0, f32x16& p1, int dq) {
    const float NEG = -__builtin_inff();
#pragma unroll
    for (int r = 0; r < 16; ++r) { const int c = (r & 3) + 8 * (r >> 2); if (dq - c < 0) p0[r] = NEG; if (dq - c - 32 < 0) p1[r] = NEG; }
}
__device__ __forceinline__ void partialSM(f32x16& p0, f32x16& p1, float& m_reg, float& mn, float& alpha) {
    float pmax = p0[0];
#pragma unroll
    for (int r = 1; r < 16; ++r) pmax = fmaxf(pmax, p0[r]);
#pragma unroll
    for (int r = 0; r < 16; ++r) pmax = fmaxf(pmax, p1[r]);
    { auto rr = __builtin_amdgcn_permlane32_swap(__float_as_uint(pmax), __float_as_uint(pmax), false, false);
      pmax = fmaxf(__uint_as_float(rr[0]), __uint_as_float(rr[1])); }
    if (__builtin_expect(__all((pmax - m_reg) <= THR2), 1)) { mn = m_reg; alpha = 1.f; }
    else { mn = fmaxf(m_reg, pmax); alpha = __builtin_amdgcn_exp2f(m_reg - mn); m_reg = mn; }
#pragma unroll
    for (int r = 0; r < 16; ++r) p0[r] = p0[r] - mn;
#pragma unroll
    for (int r = 0; r < 16; ++r) p1[r] = p1[r] - mn;
#pragma unroll
    for (int r = 0; r < 16; ++r) p0[r] = __builtin_amdgcn_exp2f(p0[r]);
}
__device__ __forceinline__ void finishSM(f32x16& p0, f32x16& p1, float alpha, float& l_reg, bf16x8& pa0, bf16x8& pa1, bf16x8& pa2, bf16x8& pa3) {
#pragma unroll
    for (int r = 0; r < 16; ++r) p1[r] = __builtin_amdgcn_exp2f(p1[r]);
    float ps = 0;
#pragma unroll
    for (int r = 0; r < 16; ++r) ps += p0[r];
#pragma unroll
    for (int r = 0; r < 16; ++r) ps += p1[r];
    { auto rr = __builtin_amdgcn_permlane32_swap(__float_as_uint(ps), __float_as_uint(ps), false, false);
      ps = __uint_as_float(rr[0]) + __uint_as_float(rr[1]); }
    l_reg = l_reg * alpha + ps;
#define PK4(P, B_, OUT) do { unsigned a0 = cvtpk(P[B_+0], P[B_+1]), a1 = cvtpk(P[B_+2], P[B_+3]);                          \
        unsigned b0 = cvtpk(P[B_+4], P[B_+5]), b1 = cvtpk(P[B_+6], P[B_+7]);                                             \
        auto r0 = __builtin_amdgcn_permlane32_swap(a0, b0, false, false); auto r1 = __builtin_amdgcn_permlane32_swap(a1, b1, false, false); \
        u32x4 w = {r0[0], r1[0], r0[1], r1[1]}; OUT = __builtin_bit_cast(bf16x8, w); } while (0)
    PK4(p0, 0, pa0); PK4(p0, 8, pa1); PK4(p1, 0, pa2); PK4(p1, 8, pa3);
#undef PK4
}
template <int KB>
__device__ __forceinline__ void qkt(f32x16& p0, f32x16& p1, FLAS const char* K_lds, FLAS const float* ctile, int r32, int hi, const bf16x8* qr) {
    FLAS const float* cl = ctile + 4 * hi;
#pragma unroll
    for (int g = 0; g < 4; ++g) { const f32x4 a = *(FLAS const f32x4*)(cl + 8 * g), b = *(FLAS const f32x4*)(cl + 32 + 8 * g);
#pragma unroll
        for (int e = 0; e < 4; ++e) { p0[4 * g + e] = a[e]; p1[4 * g + e] = b[e]; } }
    FLAS const char* kb[4];
#pragma unroll
    for (int dd = 0; dd < 4; ++dd) kb[dd] = K_lds + KB * SHM_K + KSWZ(r32, (dd * 16 + hi * 8) * 2);
#pragma unroll
    for (int d0 = 0; d0 < 8; ++d0) { FLAS const char* a = kb[d0 & 3] + (d0 >> 2) * 128;
        const bf16x8 b0 = *(FLAS const bf16x8*)(a);
        const bf16x8 b1 = *(FLAS const bf16x8*)(a + 32 * 256);
        p0 = __builtin_amdgcn_mfma_f32_32x32x16_bf16(b0, qr[d0], p0, 0, 0, 0);
        p1 = __builtin_amdgcn_mfma_f32_32x32x16_bf16(b1, qr[d0], p1, 0, 0, 0); }
}
template <int VB>
__device__ __forceinline__ void pv_tile(f32x16* o, int vb0, bf16x8 pa0, bf16x8 pa1, bf16x8 pa2, bf16x8 pa3) {
#define TRRD(dst, off) asm volatile("ds_read_b64_tr_b16 %0, %1 offset:%2" : "=&v"(dst) : "v"(vb0), "i"(off) : "memory")
#define PV_D0(d0) do { s16x4 l0, l1, l2, l3, h0, h1, h2, h3; constexpr int b_ = OFF_V + VB * SHM_V + v_rd_off(d0, 0, 0); \
        TRRD(l0, b_); TRRD(h0, b_ + 2048); TRRD(l1, b_ + 4096); TRRD(h1, b_ + 6144); TRRD(l2, b_ + 8192); TRRD(h2, b_ + 10240); TRRD(l3, b_ + 12288); TRRD(h3, b_ + 14336); \
        asm volatile("s_waitcnt lgkmcnt(0)" ::: "memory"); SBAR();   \
        o[d0] = __builtin_amdgcn_mfma_f32_32x32x16_bf16(pa0, (bf16x8){l0[0], l0[1], l0[2], l0[3], h0[0], h0[1], h0[2], h0[3]}, o[d0], 0, 0, 0);   \
        o[d0] = __builtin_amdgcn_mfma_f32_32x32x16_bf16(pa1, (bf16x8){l1[0], l1[1], l1[2], l1[3], h1[0], h1[1], h1[2], h1[3]}, o[d0], 0, 0, 0);   \
        o[d0] = __builtin_amdgcn_mfma_f32_32x32x16_bf16(pa2, (bf16x8){l2[0], l2[1], l2[2], l2[3], h2[0], h2[1], h2[2], h2[3]}, o[d0], 0, 0, 0);   \
        o[d0] = __builtin_amdgcn_mfma_f32_32x32x16_bf16(pa3, (bf16x8){l3[0], l3[1], l3[2], l3[3], h3[0], h3[1], h3[2], h3[3]}, o[d0], 0, 0, 0); } while (0)
    PV_D0(0); PV_D0(1); PV_D0(2); PV_D0(3);
#undef PV_D0
#undef TRRD
}
struct BlockRef { bf16_t* base; int P0; };
struct Seam { bf16x8 qr[8]; bf16x8 st_v0, st_v1, st_k0, st_k1; };
#define VMW() asm volatile("s_waitcnt vmcnt(0)" ::: "memory")
#define VMWN(n) asm volatile("s_waitcnt vmcnt(%0)" :: "i"(n) : "memory")
#define LD8(p) (*(const bf16x8*)(p))
#define FRESH(t_) int t_ = threadIdx.x; asm volatile("" : "+v"(t_))
#define SLOAD_H(Bp, k0) do { FRESH(t_); const unsigned toff_ = (unsigned)((t_ >> 4) * PJ + (t_ & 15) * 8); const bf16_t* tk_ = (Bp) + PC_FK + (size_t)(k0) * PJ; const bf16_t* tv_ = (Bp) + PC_FV + (size_t)(k0) * PJ; \
        S.st_v0 = LD8(tv_ + toff_); S.st_v1 = LD8(tv_ + 32 * PJ + toff_); S.st_k0 = LD8(tk_ + toff_); S.st_k1 = LD8(tk_ + 32 * PJ + toff_); } while (0)
#define SWRITE_HK(bf) do { FRESH(t_); const int kws_ = KSWZ(t_ >> 4, (t_ & 15) * 16); *(FLAS bf16x8*)(K_lds + (bf) * SHM_K + kws_) = S.st_k0; *(FLAS bf16x8*)(K_lds + (bf) * SHM_K + kws_ + 32 * 256) = S.st_k1; } while (0)
#define SWRITE_HV(bf) do { FRESH(t_); const int vst0_ = v_st(t_ >> 4, (t_ & 15) * 8), vst1_ = v_st(32 + (t_ >> 4), (t_ & 15) * 8); *(FLAS bf16x8*)(V_lds + (bf) * SHM_V + vst0_) = S.st_v0; *(FLAS bf16x8*)(V_lds + (bf) * SHM_V + vst1_) = S.st_v1; } while (0)
#define SWRITE_H(bf) do { SWRITE_HV(bf); SWRITE_HK(bf); } while (0)
__device__ __forceinline__ int prime(const BlockRef& cur, const float* nck, const float* fqg, const float* fkg, FLAS char* lds, Seam& S) {
    int tid_ = threadIdx.x; asm volatile("" : "+v"(tid_));
    const int tid = tid_, wid = __builtin_amdgcn_readfirstlane(tid >> 6), lane = tid & 63, r32 = lane & 31, hi = lane >> 5;
    FLAS char* K_lds = lds + OFF_K; FLAS float* C_lds = (FLAS float*)(lds + OFF_C);
    const unsigned qoff = (unsigned)(r32 * PJ + hi * 8);
    { const f32x4 c0 = *(const f32x4*)(nck + 4 * tid), c1 = *(const f32x4*)(nck + 2048 + 4 * tid); *(FLAS f32x4*)(C_lds + 4 * tid) = c0; *(FLAS f32x4*)(C_lds + 2048 + 4 * tid) = c1; }
#pragma unroll
    for (int d0 = 0; d0 < 8; ++d0) S.qr[d0] = LD8(cur.base + PC_FQ + (size_t)(cur.P0 + wid * QBLK) * PJ + d0 * 16 + qoff);
    __syncthreads();
    const float gq = fmaxf(fabsf(fqg[lane]), fabsf(fqg[lane + 64])), gk = fmaxf(fabsf(fkg[lane]), fabsf(fkg[lane + 64]));
    const float thresh = 2.f * (1.02f * C2F * FD * wave_max(gq) * wave_max(gk)) + 40.f;
    const float cP0 = C_lds[cur.P0], ct = C_lds[64 * lane + 63];
    const int j_lo = __builtin_amdgcn_readfirstlane(__popcll(__ballot(cP0 - ct > thresh)));
    SLOAD_H(cur.base, j_lo * KVBLK); VMW(); SWRITE_HK(0);
    __syncthreads();
    return j_lo;
}
__device__ __forceinline__ void block(const BlockRef& cur, const int j_lo, FLAS char* lds, Seam& S) {
    int tid_ = threadIdx.x; asm volatile("" : "+v"(tid_));
    const int tid = tid_, wid = __builtin_amdgcn_readfirstlane(tid >> 6), lane = tid & 63, r32 = lane & 31, hi = lane >> 5;
    const int NT = cur.P0 / KVBLK + 4 - j_lo;
    const int qlo = cur.P0 + wid * QBLK;
    FLAS char* V_lds = lds + OFF_V; FLAS char* K_lds = lds + OFF_K; FLAS float* C_lds = (FLAS float*)(lds + OFF_C);
    FLAS float* ws = (FLAS float*)(lds + OFF_WS) + wid * 64; FLAS float* li_l = ws; FLAS float* al_l = ws + 32;
    float m_reg = -1e30f, l_reg = 0; f32x16 o[4] = {};
    const bf16_t* Bh = cur.base;
#define RESC(a) do { if (__any((a) < 1.f)) { if (hi == 0) al_l[r32] = (a); asm volatile("s_waitcnt lgkmcnt(0)" ::: "memory");              \
                     _Pragma("unroll") for (int d_ = 0; d_ < 4; ++d_) _Pragma("unroll") for (int r = 0; r < 16; ++r) o[d_][r] *= al_l[crow(r, hi)]; } } while (0)
#define KBASE(t) ((j_lo + (t)) * KVBLK)
#define MASKT(P0_, P1_, t) do { const int kb_ = KBASE(t); if (kb_ + KVBLK - 1 > qlo) { FRESH(tm_); mask_tile(P0_, P1_, qlo + (tm_ & 31) - 4 * ((tm_ >> 5) & 1) - kb_); } } while (0)
#define VB0() ({ FRESH(tv_); (int)(uintptr_t)lds + v_rd_base(tv_ & 63); })
    f32x16 pA0, pA1, pB0, pB1; float mnA, mnB, alA, alB; bf16x8 pa0, pa1, pa2, pa3;
    SWRITE_HV(0); SBAR();
    if (NT > 1) { SLOAD_H(Bh, KBASE(1)); }
    SBAR(); qkt<0>(pA0, pA1, K_lds, C_lds + KBASE(0), r32, hi, S.qr);
    MASKT(pA0, pA1, 0); partialSM(pA0, pA1, m_reg, mnA, alA);
    if (NT > 1) { VMW(); SWRITE_H(1); }
    __syncthreads();
#define HALF_STEP(PX0, PX1, mnX, alX, PY0, PY1, alY, t, KB, VB, SB) do {                                                      \
        SBAR(); qkt<KB>(PX0, PX1, K_lds, C_lds + KBASE(t), r32, hi, S.qr);                                                    \
        finishSM(PY0, PY1, alY, l_reg, pa0, pa1, pa2, pa3); SBAR();                                                           \
        if ((t) + 1 < NT) { SLOAD_H(Bh, KBASE((t) + 1)); SBAR(); }                                                            \
        pv_tile<VB>(o, VB0(), pa0, pa1, pa2, pa3); MASKT(PX0, PX1, (t)); partialSM(PX0, PX1, m_reg, mnX, alX);                   \
        __syncthreads();                                                                                                      \
        if ((t) + 1 < NT) { VMW(); SWRITE_H(SB); }                                                                            \
        RESC(alX); __syncthreads(); } while (0)
    for (int t = 1; t + 1 < NT; t += 2) {
        HALF_STEP(pB0, pB1, mnB, alB, pA0, pA1, alA, t, 1, 0, 0);
        HALF_STEP(pA0, pA1, mnA, alA, pB0, pB1, alB, t + 1, 0, 1, 1);
    }
    const bool even = (NT & 1) == 0;
    if (even) { SBAR(); qkt<1>(pB0, pB1, K_lds, C_lds + KBASE(NT - 1), r32, hi, S.qr); SBAR(); }
    finishSM(pA0, pA1, alA, l_reg, pa0, pa1, pa2, pa3); SBAR();
    pv_tile<0>(o, VB0(), pa0, pa1, pa2, pa3);
    if (even) { MASKT(pB0, pB1, NT - 1); partialSM(pB0, pB1, m_reg, mnB, alB); __syncthreads(); RESC(alB);
        finishSM(pB0, pB1, alB, l_reg, pa0, pa1, pa2, pa3); SBAR(); pv_tile<1>(o, VB0(), pa0, pa1, pa2, pa3); }
    if (hi == 0) li_l[r32] = l_reg; asm volatile("s_waitcnt lgkmcnt(0)" ::: "memory");
    float rli[16];
#pragma unroll
    for (int r = 0; r < 16; ++r) rli[r] = __builtin_amdgcn_rcpf(li_l[crow(r, hi)]);
    bf16_t* Ow = cur.base + PC_FQ + (size_t)(cur.P0 + wid * QBLK) * PJ;
#pragma unroll
    for (int r = 0; r < 16; ++r) { const int orow = crow(r, hi);
#pragma unroll
        for (int d0 = 0; d0 < 4; ++d0) { const float v = o[d0][r] * rli[r];
            const float vn = __shfl_xor(v, 1);
            if ((r32 & 1) == 0) *(unsigned*)(Ow + (unsigned)(orow * PJ + d0 * 32 + r32)) = cvtpk(v, vn); } }
    __syncthreads();
#undef RESC
#undef KBASE
#undef MASKT
#undef VB0
#undef HALF_STEP
}
#undef VMW
#undef VMWN
#undef LD8
#undef SLOAD_H
#undef SWRITE_HK
#undef SWRITE_HV
#undef SWRITE_H
#undef FRESH
#undef SBAR
#undef KSWZ
__device__ __forceinline__ void phase_item(FLAS char* lds, bf16_t* proj, const float* nck, const float* fqg, const float* fkg, int bh, int qb) {
    Seam S;
    const BlockRef cur{proj + (size_t)(bh >> 3) * SEQ * PJ + (bh & 7) * FD, qb * QB};
    const int j_lo = prime(cur, nck + (size_t)bh * SEQ, fqg, fkg, lds, S);
    block(cur, j_lo, lds, S);
}
}

constexpr int NWAVES = 8, LDS_BYTES = 147456, RING_BYTES = 131072, MISC_OFF = RING_BYTES + 320;
#define GAS __attribute__((address_space(1)))
#define LAS __attribute__((address_space(3)))
#define XB_TMO      128
#define XB_XCNT(j)  (256  + 64 * (j))
#define XB_XSUB(j)  (1280 + 64 * (j))
#define XB_XGEN(j)  (2304 + 64 * (j))
#define XB_TOP      3328
#define XB_TOPGEN   3392
#define XCD_BAR_WORDS 3456
#define XB_SPIN_CAP (1u << 18)
__device__ __forceinline__ unsigned xb_ld(unsigned* p)              { return __hip_atomic_load(p, __ATOMIC_RELAXED, __HIP_MEMORY_SCOPE_AGENT); }
__device__ __forceinline__ unsigned xb_add(unsigned* p, unsigned v) { return __hip_atomic_fetch_add(p, v, __ATOMIC_RELAXED, __HIP_MEMORY_SCOPE_AGENT); }
__device__ __forceinline__ unsigned xb_xcc_id() { return (unsigned)__builtin_amdgcn_s_getreg((3 << 11) | 20) & 0xFu; }
#define XB_SPIN(cond, bar) do { unsigned _sp = 0; while (cond) { __builtin_amdgcn_s_sleep(1); \
    if ((++_sp & 255u) == 0u) { if (xb_ld(&(bar)[XB_TMO])) break; if (_sp > XB_SPIN_CAP) { atomicAdd(&(bar)[XB_TMO], 1u); break; } } } } while (0)
struct XcdBarrier { unsigned* bar; unsigned x; volatile LAS unsigned* st; };
__device__ __forceinline__ XcdBarrier xcd_barrier_post(unsigned* bar, volatile LAS unsigned* st) {
    XcdBarrier b; b.bar = bar; b.x = xb_xcc_id(); b.st = st;
    if (threadIdx.x == 0) (void)xb_add(&bar[XB_XCNT(b.x)], 1u);
    return b;
}
__device__ __forceinline__ void xcd_barrier_complete(unsigned* bar, unsigned x, unsigned& nloc, unsigned& nx) {
    const unsigned G = gridDim.x * gridDim.y * gridDim.z;
    unsigned sum, cnt, mine, sp = 0u;
    for (;;) {
        sum = 0u; cnt = 0u; mine = 0u;
#pragma unroll
        for (unsigned j = 0; j < 16; ++j) { const unsigned c = xb_ld(&bar[XB_XCNT(j)]); sum += c; cnt += (c > 0u) ? 1u : 0u; mine = (j == x) ? c : mine; }
        if (sum == G) break;
        __builtin_amdgcn_s_sleep(1);
        if ((++sp & 255u) == 0u) { if (xb_ld(&bar[XB_TMO])) break; if (sp > XB_SPIN_CAP) { atomicAdd(&bar[XB_TMO], 1u); break; } }
    }
    nloc = mine > 0u ? mine : 1u; nx = cnt > 0u ? cnt : 1u;
}
__device__ __forceinline__ void xcd_barrier(const XcdBarrier& b) {
    asm volatile("s_waitcnt vmcnt(0)" ::: "memory");
    __syncthreads();
    if (threadIdx.x == 0) {
        unsigned* bar = b.bar;
        __builtin_amdgcn_s_waitcnt(0);
        unsigned nloc = b.st[0], nx = b.st[1];
        if (nloc == 0u) { xcd_barrier_complete(bar, b.x, nloc, nx); b.st[0] = nloc; b.st[1] = nx; }
        const unsigned old = xb_add(&bar[XB_XSUB(b.x)], 1u);
        const unsigned gen = old / nloc;
        if (old + 1u == (gen + 1u) * nloc) {
            __builtin_amdgcn_fence(__ATOMIC_RELEASE, "agent");
            asm volatile("s_waitcnt vmcnt(0)" ::: "memory");
            const unsigned og = xb_add(&bar[XB_TOP], 1u);
            const unsigned tg = og / nx;
            if (og + 1u == (tg + 1u) * nx) xb_add(&bar[XB_TOPGEN], 1u);
            else XB_SPIN(xb_ld(&bar[XB_TOPGEN]) == tg, bar);
            __builtin_amdgcn_fence(__ATOMIC_ACQUIRE, "agent");
            xb_add(&bar[XB_XGEN(b.x)], 1u);
            asm volatile("s_waitcnt vmcnt(0)" ::: "memory");
        } else {
            XB_SPIN(xb_ld(&bar[XB_XGEN(b.x)]) == gen, bar);
            __builtin_amdgcn_fence(__ATOMIC_ACQUIRE, "agent");
            asm volatile("s_waitcnt vmcnt(0)" ::: "memory");
        }
    }
    __syncthreads();
}

struct TrRegs { f32x4 v[16]; };
__device__ __forceinline__ void p0_tr_load(TrRegs& R, const float* __restrict__ W, int ldw, int nblk, int remap, int item, int lane) {
    const int kb = item / nblk, nb = item - kb * nblk, k0 = 64 * kb, n0 = 64 * nb;
    const int src0 = n0 + ((remap && n0 >= OC_FL) ? 8 : 0);
    const int kr = lane >> 4, nc = (lane & 15) * 4;
    const float* wp = W + (size_t)(k0 + 2 * kr) * ldw + src0 + nc;
#pragma unroll
    for (int i = 0; i < 8; ++i) { R.v[2 * i] = __builtin_nontemporal_load((const f32x4*)(wp + (size_t)(8 * i) * ldw)); R.v[2 * i + 1] = __builtin_nontemporal_load((const f32x4*)(wp + (size_t)(8 * i + 1) * ldw)); }
}
__device__ __forceinline__ void p0_tr_store(const TrRegs& R, int K, int nblk, const float* __restrict__ g, bf16_t* __restrict__ WT, int row_off, LAS unsigned* scr, int item, int lane) {
    const int kb = item / nblk, nb = item - kb * nblk, k0 = 64 * kb, n0 = 64 * nb;
    const int kr = lane >> 4, nc = (lane & 15) * 4;
#pragma unroll
    for (int i = 0; i < 8; ++i) {
        float g0 = 1.f, g1 = 1.f; if (g) { g0 = g[k0 + 8 * i + 2 * kr]; g1 = g[k0 + 8 * i + 2 * kr + 1]; }
        const int kp = 4 * i + kr;
#pragma unroll
        for (int e = 0; e < 4; ++e) scr[(nc + e) * 33 + kp] = pk2(R.v[2 * i][e] * g0, R.v[2 * i + 1][e] * g1);
    }
    asm volatile("s_waitcnt lgkmcnt(0)" ::: "memory");
    const int cch = lane & 7;
#pragma unroll
    for (int j = 0; j < 8; ++j) { const int n = (lane >> 3) + 8 * j; const LAS unsigned* s = scr + n * 33 + 4 * cch;
        u32x4 o; o.x = s[0]; o.y = s[1]; o.z = s[2]; o.w = s[3];
        *(u32x4*)(WT + (size_t)(row_off + n0 + n) * K + k0 + 8 * cch) = o; }
    asm volatile("s_waitcnt lgkmcnt(0)" ::: "memory");
}
__device__ __forceinline__ void p0_transpose_item(const float* __restrict__ W, int ldw, int K, int nblk, const float* __restrict__ g, bf16_t* __restrict__ WT, int row_off, int remap, LAS unsigned* scr, int item, int lane) {
    TrRegs R; p0_tr_load(R, W, ldw, nblk, remap, item, lane); p0_tr_store(R, K, nblk, g, WT, row_off, scr, item, lane);
}
struct RowRegs { f32x4 v[8]; };
__device__ __forceinline__ void p0_row_load(RowRegs& R, int row, int lane, const float* __restrict__ x, const float* __restrict__ mem) {
    const float* src = row < M ? x + (size_t)row * DM : mem + (size_t)(row - M) * DM;
#pragma unroll
    for (int j = 0; j < 8; ++j) R.v[j] = __builtin_nontemporal_load((const f32x4*)(src + 256 * j + 4 * lane));
}
__device__ __forceinline__ void p0_row_proc(const RowRegs& R, int row, int lane, const float* __restrict__ b_f, bf16_t* __restrict__ hb, float* __restrict__ lf, float* __restrict__ rv, const LAS float* wfs) {
    const bool is_x = row < M;
    float ss = 0.f;
#pragma unroll
    for (int j = 0; j < 8; ++j) ss += R.v[j].x * R.v[j].x + R.v[j].y * R.v[j].y + R.v[j].z * R.v[j].z + R.v[j].w * R.v[j].w;
    ss = wave_sum(ss);
    const float r = rsqrtf(ss * (1.f / DM) + EPS);
    if (is_x && lane == 0) rv[row] = sqrtf(ss * (1.f / DM) + EPS);
    bf16_t* dst = hb + (size_t)row * DM;
#pragma unroll
    for (int j = 0; j < 8; ++j) { u32x2 w; w.x = pk2(R.v[j].x * r, R.v[j].y * r); w.y = pk2(R.v[j].z * r, R.v[j].w * r); *(u32x2*)(dst + 256 * j + 4 * lane) = w; }
    if (is_x) {
        float a[8] = {0.f, 0.f, 0.f, 0.f, 0.f, 0.f, 0.f, 0.f};
#pragma unroll
        for (int j = 0; j < 8; ++j)
#pragma unroll
            for (int e = 0; e < 4; ++e) {
                const float xv = R.v[j][e];
                const f32x4 w0 = *(const LAS f32x4*)(wfs + ((((j * 4 + e) * 2 + 0) * 64 + lane) * 4));
                const f32x4 w1 = *(const LAS f32x4*)(wfs + ((((j * 4 + e) * 2 + 1) * 64 + lane) * 4));
                a[0] += xv * w0.x; a[1] += xv * w0.y; a[2] += xv * w0.z; a[3] += xv * w0.w;
                a[4] += xv * w1.x; a[5] += xv * w1.y; a[6] += xv * w1.z; a[7] += xv * w1.w;
            }
#pragma unroll
        for (int cc = 0; cc < 8; ++cc) a[cc] = wave_sum(a[cc]);
        if (lane < 8) {
            float z = 0.f;
#pragma unroll
            for (int cc = 0; cc < 8; ++cc) z = (lane == cc) ? a[cc] : z;
            z = z * r + b_f[lane];
            const float ls = (z >= 0.f) ? -log1pf(expf(-z)) : z - log1pf(expf(z));
            lf[(size_t)row * 8 + lane] = ls;
        }
    }
}

struct Args { const float* in[19]; float* out; unsigned char* ws; int ph_lo, ph_hi; };
constexpr int NPH = 8;
__global__ void __launch_bounds__(NWAVES * 64, 2) mega(Args a) {
    extern __shared__ __attribute__((aligned(16))) unsigned char lds_raw[];
    PG8_LAS unsigned char* lds = (PG8_LAS unsigned char*)lds_raw;
    unsigned char* ws = a.ws;
    const int G = gridDim.x, c = blockIdx.x;
#define FRESH_TID() int tid = threadIdx.x; asm volatile("" : "+v"(tid)); const int lane = tid & 63; const int wave = __builtin_amdgcn_readfirstlane(tid >> 6); (void)lane; (void)wave;
    bf16_t* hb = (bf16_t*)(ws + WS_HB); bf16_t* proj = (bf16_t*)(ws + WS_PROJ); bf16_t* gates = (bf16_t*)(ws + WS_GATES); bf16_t* kv = (bf16_t*)(ws + WS_KV); bf16_t* vmT = (bf16_t*)(ws + WS_VMT); bf16_t* PM = (bf16_t*)(ws + WS_PM);
    float* lf = (float*)(ws + WS_LF); float* nck = (float*)(ws + WS_NCK);
    float* ssp = (float*)(ws + WS_SSP); bf16_t* merged = (bf16_t*)(ws + WS_MERGED); bf16_t* U = (bf16_t*)(ws + WS_U); bf16_t* x1b = (bf16_t*)(ws + WS_X1B);
    volatile LAS unsigned* MISC = (volatile LAS unsigned*)(lds + MISC_OFF);
    if (threadIdx.x < 32) MISC[threadIdx.x] = 0u;
    __syncthreads();
    const bool multi = (a.ph_hi - a.ph_lo) > 1;
    XcdBarrier bar; bar.bar = (unsigned*)(ws + WS_CTL); bar.x = 0; bar.st = nullptr;
    if (multi) bar = xcd_barrier_post((unsigned*)(ws + WS_CTL), MISC + 8);
#define IN(k) (a.ph_lo <= (k) && (k) < a.ph_hi)
#define SEAM(k) do { if (IN(k) && IN((k) + 1)) xcd_barrier(bar); } while (0)
    if (IN(0)) {
        FRESH_TID();
        const float* x = a.in[0]; const float* mem = a.in[1]; const float* g1 = a.in[2]; const float* w_in = a.in[3]; const float* b_f = a.in[4];
        __syncthreads();
        LAS float* wfs = (LAS float*)lds;
        const int gw = c * NWAVES + wave, ngw = G * NWAVES;
        RowRegs cur; int row = gw;
        if (row < M + BATCH * MT) p0_row_load(cur, row, lane, x, mem);
        { f32x4 wa[4], wb[4]; float gg[4];
#pragma unroll
          for (int e = 0; e < 4; ++e) { const int k = 4 * tid + e; const float* p = w_in + (size_t)k * IN_COLS + OC_FL; wa[e] = *(const f32x4*)p; wb[e] = *(const f32x4*)(p + 4); gg[e] = g1[k]; }
          const int j = tid >> 6, l = tid & 63;
#pragma unroll
          for (int e = 0; e < 4; ++e) { *(LAS f32x4*)(wfs + ((((j * 4 + e) * 2 + 0) * 64 + l) * 4)) = wa[e] * gg[e]; *(LAS f32x4*)(wfs + ((((j * 4 + e) * 2 + 1) * 64 + l) * 4)) = wb[e] * gg[e]; } }
        __syncthreads();
        while (row < M + BATCH * MT) {
            RowRegs nxt; const int nrow = row + ngw;
            if (nrow < M + BATCH * MT) p0_row_load(nxt, nrow, lane, x, mem);
            p0_row_proc(cur, row, lane, b_f, hb, lf, (float*)(ws + WS_RV), wfs);
            cur = nxt; row = nrow;
        }
        __syncthreads();
        LAS unsigned* scr = (LAS unsigned*)(lds + wave * 8448);
        bf16_t* WinT = (bf16_t*)(ws + WS_WIN);
        constexpr int I_IN = (DM / 64) * (NPACK / 64), I_KV = (DM / 64) * (2048 / 64);
        constexpr int NITEMS = I_IN + I_KV;
        {
            TrRegs cur_t; int it = gw;
            if (it < NITEMS) { if (it < I_IN) p0_tr_load(cur_t, w_in, IN_COLS, NPACK / 64, 1, it, lane); else p0_tr_load(cur_t, a.in[9], 2048, 2048 / 64, 0, it - I_IN, lane); }
            while (it < NITEMS) {
                TrRegs nxt_t; const int nit = it + ngw;
                if (nit < NITEMS) { if (nit < I_IN) p0_tr_load(nxt_t, w_in, IN_COLS, NPACK / 64, 1, nit, lane); else p0_tr_load(nxt_t, a.in[9], 2048, 2048 / 64, 0, nit - I_IN, lane); }
                if (it < I_IN) p0_tr_store(cur_t, DM, NPACK / 64, g1, WinT, 0, scr, it, lane); else p0_tr_store(cur_t, DM, 2048 / 64, a.in[8], WinT, NPACK, scr, it - I_IN, lane);
                cur_t = nxt_t; it = nit;
            }
        }
    }
    SEAM(0);
    if (IN(1)) { pg8::SchedP1 S{(unsigned)WS_HB, (unsigned)WS_WIN, G, c}; pg8::EpiP1 E{proj, gates, kv, vmT, a.in[6], a.in[7], a.in[10], a.in[11], a.in[5]}; pg8::gemm_phase<pg8::EpiP1, pg8::SchedP1, true, true, true>(ws, lds, DM, DM, DM, S, E);
        constexpr int NUNITS1 = pg8::P1_NUNITS;
        const int nfull = NUNITS1 % G;
        if (nfull == 0 || c >= nfull) {
            FRESH_TID();
            const int f = nfull ? c - nfull : c, nf = nfull ? G - nfull : G;
            for (int bh = f; bh < BATCH * FH; bh += nf) { elem_scan(bh, tid, lf, nck, (LAS float*)(lds + pg8::XCH_OFF)); __syncthreads(); }
            LAS unsigned* scr = (LAS unsigned*)(lds + wave * 8448);
            constexpr int I_C3 = 3 * (1024 / 64) * (DM / 64), I_O = (DM / 64) * (DM / 64), I_UP = (DM / 64) * (DFF / 64), I_ALL = I_C3 + I_O + I_UP;
#define TC_DESC(r, src, ldw, K, nblk, g, dst, it) do { \
                if ((r) < I_C3) { const int s_ = (r) / (I_C3 / 3); src = 12 + s_; ldw = DM; K = 1024; nblk = DM / 64; g = 0; dst = WS_WC + (size_t)s_ * DM * 1024 * 2; it = (r) - s_ * (I_C3 / 3); } \
                else if ((r) < I_C3 + I_O) { src = 15; ldw = DM; K = DM; nblk = DM / 64; g = 0; dst = WS_WOUT; it = (r) - I_C3; } \
                else { src = 17; ldw = DFF; K = DM; nblk = DFF / 64; g = 1; dst = WS_WUP; it = (r) - I_C3 - I_O; } } while (0)
            struct TcD { int src, ld, K, nb, g, it; size_t dst; };
            const int stride = nf * NWAVES;
            TrRegs t0, t1, t2; TcD d0{12, DM, 1024, DM / 64, 0, 0, WS_WC}, d1 = d0, d2 = d0;
            int r0 = f * NWAVES + wave, r1 = r0 + stride, r2 = r1 + stride;
            if (r0 < I_ALL) { TC_DESC(r0, d0.src, d0.ld, d0.K, d0.nb, d0.g, d0.dst, d0.it); p0_tr_load(t0, a.in[d0.src], d0.ld, d0.nb, 0, d0.it, lane); }
            if (r1 < I_ALL) { TC_DESC(r1, d1.src, d1.ld, d1.K, d1.nb, d1.g, d1.dst, d1.it); p0_tr_load(t1, a.in[d1.src], d1.ld, d1.nb, 0, d1.it, lane); }
#pragma unroll 1
            while (r0 < I_ALL) {
                if (r2 < I_ALL) { TC_DESC(r2, d2.src, d2.ld, d2.K, d2.nb, d2.g, d2.dst, d2.it); p0_tr_load(t2, a.in[d2.src], d2.ld, d2.nb, 0, d2.it, lane); }
                p0_tr_store(t0, d0.K, d0.nb, d0.g ? a.in[16] : nullptr, (bf16_t*)(ws + d0.dst), 0, scr, d0.it, lane);
                t0 = t1; d0 = d1; r0 = r1; t1 = t2; d1 = d2; r1 = r2; r2 += stride;
            }
#undef TC_DESC
        }
    }
    SEAM(1);
    if (IN(3)) {
        constexpr int Q_FOX = 256, Q_CONV = Q_FOX + 256, Q_MEM = Q_CONV + 128, Q_END = Q_MEM + 256;
        unsigned* qctr = (unsigned*)(ws + WS_CTL) + 4096;
#pragma unroll 1
        for (;;) {
            __syncthreads();
            int moff = MISC_OFF + 64; asm volatile("" : "+s"(moff));
            volatile LAS unsigned* mbox = (volatile LAS unsigned*)(lds + moff);
            if (threadIdx.x == 0) *mbox = atomicAdd(qctr, 1u);
            __syncthreads();
            const int it = __builtin_amdgcn_readfirstlane((int)*mbox);
            if (it >= Q_END) break;
            if (it < Q_FOX) fox::phase_item((FLAS char*)lds, proj, nck, a.in[6], a.in[7], it & 15, 15 - (it >> 4));
            else if (it < Q_CONV) { const int L = it - Q_FOX; pg8::Unit u; u.pm = L >> 3; u.pn = L & 7; u.seg = 0;
                u.A = (unsigned)WS_PROJ + ((unsigned)u.pm * 256 * PJ + PC_BG) * 2; u.B = (unsigned)WS_WC + (unsigned)u.pn * 256 * 1024 * 2;
                pg8::SchedOne S{u}; pg8::EpiP3 E{gates, (bf16_t*)a.out, merged}; pg8::gemm_phase(ws, lds, PJ, 1024, 1024, S, E); }
            else if (it < Q_MEM) { const int f = it - Q_CONV, b = f >> 6, hm = (f >> 4) & 3, qb = f & 15;
                { pg8::Unit u; u.pm = b * 16 + qb; u.pn = 0; u.seg = hm;
                  u.A = (unsigned)WS_PROJ + ((unsigned)u.pm * 256 * PJ + PC_MQ + hm * MD) * 2; u.B = (unsigned)WS_KV + ((unsigned)b * MT * 2048 + hm * MD) * 2;
                  pg8::SchedOne S{u}; pg8::EpiMemS E{PM}; pg8::gemm_phase(ws, lds, PJ, 2048, MD, S, E); }
                { pg8::Unit u; u.pm = b * 16 + qb; u.pn = 0; u.seg = hm;
                  u.A = (unsigned)WS_PM + ((unsigned)u.pm * 256 * 1024 + hm * MT) * 2; u.B = (unsigned)WS_VMT + (unsigned)(b * MH + hm) * MD * MT * 2;
                  pg8::SchedOne S{u}; pg8::EpiPlain E{proj + PC_MQ + hm * MD, PJ}; pg8::gemm_phase(ws, lds, 1024, MT, MT, S, E); } }
            else { FRESH_TID();
                LAS unsigned* scr = (LAS unsigned*)(lds + wave * 8448);
                const int i0 = (it - Q_MEM) * 16 + wave * 2;
                TrRegs ta, tb; p0_tr_load(ta, a.in[18], DM, DM / 64, 0, i0, lane); p0_tr_load(tb, a.in[18], DM, DM / 64, 0, i0 + 1, lane);
                p0_tr_store(ta, DFF, DM / 64, nullptr, (bf16_t*)(ws + WS_WDN), 0, scr, i0, lane); p0_tr_store(tb, DFF, DM / 64, nullptr, (bf16_t*)(ws + WS_WDN), 0, scr, i0 + 1, lane); }
        }
    }
    SEAM(3);
    if (IN(4)) { pg8::SchedP3 S{(unsigned)WS_PROJ, (unsigned)WS_WC, G, c}; pg8::EpiP3 E{gates, (bf16_t*)a.out, merged}; pg8::gemm_phase(ws, lds, PJ, 1024, 1024, S, E); }
    SEAM(4);
    if (IN(5)) { pg8::SchedG S{(unsigned)WS_MERGED, (unsigned)WS_WOUT, DM, DM, M / 256, DM / 256, G, c}; pg8::EpiP4 E{(const float*)(ws + WS_RV), x1b, ssp}; pg8::gemm_phase(ws, lds, DM, DM, DM, S, E); }
    SEAM(5);
    if (IN(6)) { pg8::SchedG S{(unsigned)WS_X1B, (unsigned)WS_WUP, DM, DM, M / 256, DFF / 256, G, c}; pg8::EpiP5 E{ssp, U}; pg8::gemm_phase<pg8::EpiP5, pg8::SchedG, true, true, true>(ws, lds, DM, DM, DM, S, E); }
    SEAM(6);
    if (IN(7)) { pg8::SchedG S{(unsigned)WS_U, (unsigned)WS_WDN, DFF, DFF, M / 256, DM / 256, G, c}; pg8::EpiP6 E{a.out, x1b}; pg8::gemm_phase(ws, lds, DFF, DFF, DFF, S, E); }
#undef IN
#undef SEAM
}

#ifndef N_LAUNCHES
#define N_LAUNCHES 1
#endif
extern "C" void kernel_launch(void* const* d_in, const int* in_sizes, int n_in, void* d_out, int out_size, void* d_ws, size_t ws_size, hipStream_t stream) {
    if (n_in != 19 || in_sizes[0] != M * DM || out_size != M * DM || ws_size < WS_END) {
        fprintf(stderr, "kernel_launch: unexpected shapes (n_in %d, in0 %d, out %d, ws %zu < %zu)\n", n_in, n_in > 0 ? in_sizes[0] : -1, out_size, ws_size, (size_t)WS_END); return; }
    static bool attr = false; static int grid = 256;
    if (!attr) { attr = true;
        if (hipFuncSetAttribute((const void*)mega, hipFuncAttributeMaxDynamicSharedMemorySize, LDS_BYTES) != hipSuccess) fprintf(stderr, "kernel_launch: hipFuncSetAttribute(mega) failed\n");
        int dev = 0, cus = 0; if (hipGetDevice(&dev) == hipSuccess && hipDeviceGetAttribute(&cus, hipDeviceAttributeMultiprocessorCount, dev) == hipSuccess && cus > 0) grid = cus; }
    if (grid < pg8::P1_NTRI) { fprintf(stderr, "kernel_launch: grid %d < %d conv-branch unit triples\n", grid, pg8::P1_NTRI); return; }
    Args ka{}; for (int i = 0; i < 19; ++i) ka.in[i] = (const float*)d_in[i]; ka.out = (float*)d_out; ka.ws = (unsigned char*)d_ws;
    if (N_LAUNCHES == 1) {
        (void)hipMemsetAsync((char*)d_ws + WS_CTL, 0, 65536, stream);
        ka.ph_lo = 0; ka.ph_hi = NPH; hipLaunchKernelGGL(mega, dim3(grid), dim3(NWAVES * 64), LDS_BYTES, stream, ka);
    } else {
        for (int p = 0; p < NPH; ++p) { ka.ph_lo = p; ka.ph_hi = p + 1; hipLaunchKernelGGL(mega, dim3(grid), dim3(NWAVES * 64), LDS_BYTES, stream, ka); }
    }
}
```

```cpp
#include <hip/hip_runtime.h>
#include <hip/hip_bf16.h>
#include <cstdio>
#include <cstdint>

typedef unsigned short bf16_t;
typedef short bf16x8 __attribute__((ext_vector_type(8)));
typedef float f32x4 __attribute__((ext_vector_type(4)));
typedef float f32x16 __attribute__((ext_vector_type(16)));
typedef unsigned u32x4 __attribute__((ext_vector_type(4)));
typedef unsigned u32x2 __attribute__((ext_vector_type(2)));

constexpr int BATCH = 2, SEQ = 4096, DM = 2048, M = BATCH * SEQ;
constexpr int CW = 1024, FH = 8, FD = 128, MT = 256, MH = 4, MD = 256, DFF = 8192;
constexpr int IN_COLS = 13320, OC_FL = 6144;
constexpr int NPACK = 13312;
constexpr int PJ = 7168;
constexpr int PC_BG = 0, PC_CG = 1024, PC_V = 2048, PC_FQ = 3072, PC_FK = 4096, PC_FV = 5120, PC_MQ = 6144;
constexpr int NG = 6144;
constexpr float EPS = 1e-6f;
constexpr float LOG2E = 1.4426950408889634f;
constexpr float C2F = 0.08838834764831845f * LOG2E;
constexpr float C2M = 0.0625f * LOG2E;

constexpr size_t MiB = 1u << 20;
constexpr size_t WS_CTL = 0;
constexpr size_t WS_WIN = 1 * MiB;
constexpr size_t WS_WC = 61 * MiB;
constexpr size_t WS_WOUT = 73 * MiB;
constexpr size_t WS_WUP = 81 * MiB;
constexpr size_t WS_WDN = 113 * MiB;
constexpr size_t WS_HB = 145 * MiB;
constexpr size_t WS_PROJ = 179 * MiB;
constexpr size_t WS_GATES = 291 * MiB;
constexpr size_t WS_KV = 387 * MiB;
constexpr size_t WS_VMT = 389 * MiB;
constexpr size_t WS_PM = 390 * MiB;
constexpr size_t WS_LF = 406 * MiB;
constexpr size_t WS_NCK = WS_LF + 256 * 1024;
constexpr size_t WS_RV = WS_LF + 512 * 1024;
constexpr size_t WS_SSP = 407 * MiB;
constexpr size_t WS_BGE = WS_LF + 768 * 1024;
constexpr size_t WS_END = 408 * MiB;
constexpr size_t WS_MERGED = WS_WIN;
constexpr size_t WS_U = WS_PROJ;
constexpr size_t WS_X1B = WS_HB;

__device__ __forceinline__ float bf2f(bf16_t v) { return __uint_as_float(((unsigned)v) << 16); }
__device__ __forceinline__ bf16_t f2bf(float f) { unsigned u = __float_as_uint(f); return (bf16_t)((u + 0x7fffu + ((u >> 16) & 1u)) >> 16); }
__device__ __forceinline__ unsigned pk2(float lo, float hi) { return (unsigned)f2bf(lo) | ((unsigned)f2bf(hi) << 16); }
__device__ __forceinline__ float wave_sum(float v) {
#pragma unroll
    for (int o = 1; o < 64; o <<= 1) v += __shfl_xor(v, o);
    return v;
}
__device__ __forceinline__ float wave_max(float v) {
#pragma unroll
    for (int o = 1; o < 64; o <<= 1) v = fmaxf(v, __shfl_xor(v, o));
    return v;
}
__device__ __forceinline__ void unpack8(u32x4 w, float* v) {
    v[0] = __uint_as_float(w.x << 16); v[1] = __uint_as_float(w.x & 0xffff0000u);
    v[2] = __uint_as_float(w.y << 16); v[3] = __uint_as_float(w.y & 0xffff0000u);
    v[4] = __uint_as_float(w.z << 16); v[5] = __uint_as_float(w.z & 0xffff0000u);
    v[6] = __uint_as_float(w.w << 16); v[7] = __uint_as_float(w.w & 0xffff0000u);
}
__device__ __forceinline__ u32x4 pack8f(const float* v) { u32x4 w; w.x = pk2(v[0], v[1]); w.y = pk2(v[2], v[3]); w.z = pk2(v[4], v[5]); w.w = pk2(v[6], v[7]); return w; }

__device__ __forceinline__ void elem_scan(int bh, int tid, const float* __restrict__ lf, float* __restrict__ nck, __attribute__((address_space(3))) float* xs) {
    const int b = bh >> 3, h = bh & 7, lane = tid & 63, wave = tid >> 6;
    const float* src = lf + ((size_t)b * SEQ + 8 * tid) * 8 + h;
    float v[8];
#pragma unroll
    for (int e = 0; e < 8; ++e) v[e] = src[e * 8];
    float s = 0.f;
#pragma unroll
    for (int e = 0; e < 8; ++e) { s += v[e]; v[e] = s; }
    float incl = s;
#pragma unroll
    for (int o = 1; o < 64; o <<= 1) { const float n = __shfl_up(incl, o); if (lane >= o) incl += n; }
    if (lane == 63) xs[wave] = incl;
    __syncthreads();
    float off = incl - s;
    for (int w = 0; w < wave; ++w) off += xs[w];
    f32x4 o0, o1;
#pragma unroll
    for (int e = 0; e < 4; ++e) { o0[e] = -(off + v[e]) * LOG2E; o1[e] = -(off + v[4 + e]) * LOG2E; }
    float* dst = nck + (size_t)bh * SEQ + 8 * tid;
    *(f32x4*)dst = o0; *(f32x4*)(dst + 4) = o1;
}

namespace pg8 {
#define PG8_LAS __attribute__((address_space(3)))
constexpr int BM = 256, BK = 64, HALF = 128, HTB = HALF * BK * 2, STAGE_BYTES = 8 * HTB, NXCD = 8, WGM = 4;
__host__ __device__ __forceinline__ int lds_byte(int r, int c) { const int st = (r >> 4) * 2 + (c >> 5), rr = r & 15, cc = c & 31, ob = rr * 64 + cc * 2; return st * 1024 + (ob ^ (((ob >> 9) & 1) << 5)); }
__host__ __device__ __forceinline__ void stage_rc(int b, int& R, int& C) { const int st = b / 1024, sb = b % 1024, swz = sb ^ (((sb >> 9) & 1) << 5); R = (st >> 1) * 16 + swz / 64; C = (st & 1) * 32 + (swz % 64) / 2; }
__host__ __device__ __forceinline__ int perm32(int rho) { const int n = rho >> 4, i = rho & 15; return 8 * (i >> 2) + 4 * n + (i & 3); }
struct Unit { unsigned A, B; int pm, pn, seg; };
typedef __amdgpu_buffer_rsrc_t Rsrc;
__device__ __forceinline__ void tile_of(int L, int nM, int nN, int& pm, int& pn) {
    const int nwg = nM * nN; int wgid = L;
    { const int q = nwg / NXCD, r = nwg % NXCD, xcd = wgid % NXCD, off = wgid / NXCD; wgid = (xcd < r ? xcd * (q + 1) : r * (q + 1) + (xcd - r) * q) + off; }
    const int nig = WGM * nN, gid = wgid / nig, fm = gid * WGM, gsz = (nM - fm) < WGM ? (nM - fm) : WGM;
    pm = fm + ((wgid % nig) % gsz); pn = (wgid % nig) / gsz;
}
__device__ __forceinline__ unsigned cvt_pk_bf16(float lo, float hi) { unsigned r; asm volatile("v_cvt_pk_bf16_f32 %0, %1, %2" : "=v"(r) : "v"(lo), "v"(hi)); return r; }
template <class S> struct sched_has_ready { template <class T> static char f(decltype(&T::ready)); template <class T> static long f(...); static constexpr bool value = sizeof(f<S>(nullptr)) == 1; };
template <class Epi, class Sched, bool ALIGN_EPI = true, bool SP2 = true, bool PEEL = false, int NSEG = 1>
__device__ __forceinline__ void gemm_phase(unsigned char* wsb, PG8_LAS unsigned char* lds, const int lda, const int ldb, const int K, const Sched& S, const Epi& E, const unsigned segA = 0u, const unsigned segB = 0u) {
    int tid_ = threadIdx.x; asm volatile("" : "+v"(tid_));
    asm volatile("" : "+s"(wsb));
    const Rsrc rs = __builtin_amdgcn_make_buffer_rsrc((void*)wsb, 0, -1, 0x00020000);
    const int tid = tid_, wid = __builtin_amdgcn_readfirstlane(tid >> 6), lane = tid & 63, wr = wid >> 2, wc = wid & 3, fr = lane & 15, fq = lane >> 4;
    const int nt = K / BK;
    unsigned voffA[2], voffB[2];
#pragma unroll
    for (int i = 0; i < 2; ++i) { int R, C; stage_rc(tid * 16 + i * 8192, R, C); const int Rb = (R & ~31) + perm32(R & 31);
        voffA[i] = (unsigned)(R * lda + C) * 2u; voffB[i] = (unsigned)(Rb * ldb + C) * 2u; }
    const unsigned kstep = (unsigned)(BK * 2);
    const unsigned hstepA = (unsigned)HALF * lda * 2, hstepB = (unsigned)HALF * ldb * 2;
    const unsigned ldsw = (unsigned)wid * 1024u;
    const int aoff = lds_byte(wr * 64 + fr, fq * 8), boff = lds_byte(wc * 32 + fr, fq * 8);
#define PG8_SA(b, h) (((b) * 2 + (h)) * HTB)
#define PG8_SB(b, h) ((4 + (b) * 2 + (h)) * HTB)
#define PG8_STAGE(bufoff, soff, voff) do { _Pragma("unroll") for (int _i = 0; _i < 2; ++_i) \
        __builtin_amdgcn_raw_ptr_buffer_load_lds(rs, (PG8_LAS void*)(lds + (bufoff) + ldsw + _i * 8192), 16, (int)(voff)[_i], (int)(soff), 0, 0); } while (0)
#define PG8_LDA(dst, b, h) do { _Pragma("unroll") for (int m = 0; m < 4; ++m) _Pragma("unroll") for (int k = 0; k < 2; ++k) dst[m][k] = *(const PG8_LAS bf16x8*)(lds + PG8_SA(b, h) + aoff + m * 2048 + k * 1024); } while (0)
#define PG8_LDB(dst, b, h) do { _Pragma("unroll") for (int n = 0; n < 2; ++n) _Pragma("unroll") for (int k = 0; k < 2; ++k) dst[n][k] = *(const PG8_LAS bf16x8*)(lds + PG8_SB(b, h) + boff + n * 2048 + k * 1024); } while (0)
#define PG8_MMA(ai, bj, At, Bt) do { __builtin_amdgcn_s_setprio(1); _Pragma("unroll") for (int m = 0; m < 4; ++m) _Pragma("unroll") for (int n = 0; n < 2; ++n) _Pragma("unroll") for (int k = 0; k < 2; ++k) \
        acc[ai][bj][m][n] = __builtin_amdgcn_mfma_f32_16x16x32_bf16(Bt[n][k], At[m][k], acc[ai][bj][m][n], 0, 0, 0); __builtin_amdgcn_s_setprio(0); } while (0)
#define PG8_WAIT_V(n) asm volatile("s_waitcnt vmcnt(" #n ")" ::: "memory")
#define PG8_WAIT_L(n) asm volatile("s_waitcnt lgkmcnt(" #n ")" ::: "memory")
#define PG8_BAR __builtin_amdgcn_s_barrier()
#define PG8_SCHED __builtin_amdgcn_sched_barrier(0)
    Unit cur, nxt; int ui = 0;
    if (!S.next(0, cur)) return;
    f32x4 acc[2][2][4][2];
#pragma unroll
    for (int a = 0; a < 2; ++a)
#pragma unroll
        for (int b = 0; b < 2; ++b)
#pragma unroll
            for (int m = 0; m < 4; ++m)
#pragma unroll
                for (int n = 0; n < 2; ++n) acc[a][b][m][n] = (f32x4){0.f, 0.f, 0.f, 0.f};
    bf16x8 At[4][2], B0[2][2], B1[2][2];
    unsigned cA = cur.A, cB = cur.B;
    if constexpr (SP2) {
        PG8_STAGE(PG8_SB(0, 0), cB, voffB); PG8_STAGE(PG8_SB(0, 1), cB + hstepB, voffB); PG8_STAGE(PG8_SA(0, 0), cA, voffA); PG8_STAGE(PG8_SA(0, 1), cA + hstepA, voffA);
        PG8_STAGE(PG8_SB(1, 0), cB + kstep, voffB); PG8_STAGE(PG8_SA(1, 0), cA + kstep, voffA); PG8_STAGE(PG8_SB(1, 1), cB + hstepB + kstep, voffB);
        if (wr == 1) PG8_BAR;
        PG8_WAIT_V(8); PG8_BAR;
        PG8_WAIT_V(6); PG8_BAR;
    } else {
        PG8_STAGE(PG8_SB(0, 0), cB, voffB); PG8_STAGE(PG8_SA(0, 0), cA, voffA); PG8_STAGE(PG8_SB(0, 1), cB + hstepB, voffB); PG8_STAGE(PG8_SA(0, 1), cA + hstepA, voffA);
        if (wr == 1) PG8_BAR;
        PG8_WAIT_V(4); PG8_BAR;
        PG8_STAGE(PG8_SB(1, 0), cB + kstep, voffB); PG8_STAGE(PG8_SA(1, 0), cA + kstep, voffA); PG8_STAGE(PG8_SB(1, 1), cB + hstepB + kstep, voffB);
        PG8_WAIT_V(6); PG8_BAR;
    }
    for (;;) {
        const bool has_next = S.next(ui + 1, nxt);
        const unsigned dmy = (unsigned)(nt - 2) * kstep;
        const unsigned nA = has_next ? nxt.A : cA + dmy, nB = has_next ? nxt.B : cB + dmy;
#define PG8_TRIP(t, W, BA, BB, NA, NB) do { \
            const bool last = ((t) == nt - 2); \
            const unsigned a1 = (BA) + (unsigned)((t) + 1) * kstep; \
            const unsigned a2 = last ? (NA) : (BA) + (unsigned)((t) + 2) * kstep, b2 = last ? (NB) : (BB) + (unsigned)((t) + 2) * kstep; \
            const unsigned a3 = a2 + kstep, b3 = b2 + kstep; \
            PG8_LDB(B0, 0, 0); PG8_LDB(B1, 0, 1); PG8_SCHED; PG8_LDA(At, 0, 0); PG8_STAGE(PG8_SA(1, 1), a1 + hstepA, voffA); \
            PG8_WAIT_V(W); PG8_WAIT_L(0); PG8_BAR; PG8_MMA(0, 0, At, B0); PG8_MMA(0, 1, At, B1); PG8_BAR; PG8_SCHED; \
            PG8_LDA(At, 0, 1); PG8_STAGE(PG8_SB(0, 0), b2, voffB); PG8_STAGE(PG8_SB(0, 1), b2 + hstepB, voffB); PG8_STAGE(PG8_SA(0, 0), a2, voffA); \
            PG8_WAIT_V(W); PG8_WAIT_L(0); PG8_BAR; PG8_MMA(1, 0, At, B0); PG8_MMA(1, 1, At, B1); PG8_BAR; PG8_SCHED; \
            PG8_LDB(B0, 1, 0); PG8_LDB(B1, 1, 1); PG8_SCHED; PG8_LDA(At, 1, 0); PG8_STAGE(PG8_SA(0, 1), a2 + hstepA, voffA); \
            PG8_WAIT_V(8); PG8_WAIT_L(0); PG8_BAR; PG8_MMA(0, 0, At, B0); PG8_MMA(0, 1, At, B1); PG8_BAR; PG8_SCHED; \
            PG8_LDA(At, 1, 1); PG8_STAGE(PG8_SB(1, 0), b3, voffB); PG8_STAGE(PG8_SB(1, 1), b3 + hstepB, voffB); PG8_STAGE(PG8_SA(1, 0), a3, voffA); \
            PG8_WAIT_V(8); PG8_WAIT_L(0); PG8_BAR; PG8_MMA(1, 0, At, B0); PG8_MMA(1, 1, At, B1); PG8_BAR; PG8_SCHED; } while (0)
        static_assert(SP2, "this build keeps only the two-MFMA-blocks-per-barrier-pair schedule");
        if constexpr (NSEG == 1) {
            int t0 = 0;
            if constexpr (PEEL) { if (ui > 0) { PG8_TRIP(0, 24, cA, cB, nA, nB); t0 = 2; } }
            for (int t = t0; t < nt; t += 2) PG8_TRIP(t, 8, cA, cB, nA, nB);
        } else {
            static_assert(!PEEL || NSEG == 1, "segmented units are not peeled");
#pragma unroll 1
            for (int sg = 0; sg < NSEG; ++sg) {
                if (sg) E.mid(acc, cur, sg, wr, wc, fr, fq);
                const unsigned sA = cA + (unsigned)sg * segA, sB = cB + (unsigned)sg * segB;
                const unsigned xA = sg == NSEG - 1 ? nA : sA + segA, xB = sg == NSEG - 1 ? nB : sB + segB;
                for (int t = 0; t < nt; t += 2) PG8_TRIP(t, 8, sA, sB, xA, xB);
            }
        }
#undef PG8_TRIP
        if constexpr (ALIGN_EPI) { if (wr == 0) PG8_BAR; }
        E(acc, cur, wr, wc, fr, fq, lds);
        if constexpr (sched_has_ready<Sched>::value) { if (ui == Sched::READY_UNIT) { PG8_WAIT_V(0); PG8_BAR; S.ready(); } }
        if (!has_next) break;
#pragma unroll
        for (int a = 0; a < 2; ++a)
#pragma unroll
            for (int b = 0; b < 2; ++b)
#pragma unroll
                for (int m = 0; m < 4; ++m)
#pragma unroll
                    for (int n = 0; n < 2; ++n) acc[a][b][m][n] = (f32x4){0.f, 0.f, 0.f, 0.f};
        cur = nxt; cA = nA; cB = nB; ++ui;
        if constexpr (ALIGN_EPI) { if (wr == 1) PG8_BAR; }
    }
    PG8_WAIT_V(0);
    if constexpr (!ALIGN_EPI) { if (wr == 0) PG8_BAR; }
    PG8_BAR;
#undef PG8_SA
#undef PG8_SB
#undef PG8_STAGE
#undef PG8_LDA
#undef PG8_LDB
#undef PG8_MMA
#undef PG8_WAIT_V
#undef PG8_WAIT_L
#undef PG8_BAR
#undef PG8_SCHED
}
typedef f32x4 Acc[2][2][4][2];
constexpr int XCH_OFF = 131072 + 1024;

struct EpiP1 { bf16_t* proj; unsigned char* gates; bf16_t* kv; bf16_t* vmT; const float* fqg; const float* fkg; const float* mqg; const float* mkg; const float* conv_w;
    __device__ __forceinline__ void operator()(Acc& acc, const Unit& u, int wr, int wc, int fr, int fq, PG8_LAS unsigned char* lds) const {
        asm volatile("" : "+v"(fr), "+v"(fq));
        bf16_t* base; int ldc; int kind = 0; int colt = u.pn * BM;
        if (u.seg == 1) { base = kv; ldc = 2048; kind = 3; }
        else if (u.seg == 2) { base = vmT + (size_t)u.pn * (MD * MT); ldc = MT; colt = 0; }
        else if (u.pn < PJ / BM) { base = proj; ldc = PJ; kind = u.seg >= 4 ? u.seg : ((u.pn >= PC_FQ / BM && u.pn < PC_FV / BM) ? 2 : (u.pn >= PC_MQ / BM ? 3 : 0)); }
        else { base = proj; ldc = NG; colt -= PJ; kind = 1; }
        const int row0 = u.pm + wr * 64 + fr, col0 = colt + wc * 32 + 8 * fq;
        if (kind == 4) {
#pragma unroll
            for (int ai = 0; ai < 2; ++ai) { u32x4 Cq[4][2];
#pragma unroll
                for (int m = 0; m < 4; ++m)
#pragma unroll
                    for (int bj = 0; bj < 2; ++bj) Cq[m][bj] = *(const u32x4*)((const char*)base + (unsigned)((row0 + ai * HALF + m * 16) * PJ + col0 + bj * HALF - (PC_V - PC_CG)) * 2u);
#pragma unroll
                for (int m = 0; m < 4; ++m)
#pragma unroll
                    for (int bj = 0; bj < 2; ++bj) { float g[8]; unpack8(Cq[m][bj], g);
                        f32x4 v0 = acc[ai][bj][m][0], v1 = acc[ai][bj][m][1];
#pragma unroll
                        for (int e = 0; e < 4; ++e) { v0[e] *= g[e]; v1[e] *= g[4 + e]; }
                        u32x4 w; w.x = cvt_pk_bf16(v0[0], v0[1]); w.y = cvt_pk_bf16(v0[2], v0[3]); w.z = cvt_pk_bf16(v1[0], v1[1]); w.w = cvt_pk_bf16(v1[2], v1[3]);
                        *(u32x4*)((char*)base + (unsigned)((row0 + ai * HALF + m * 16) * PJ + col0 + bj * HALF) * 2u) = w; }
                asm volatile("" ::: "memory"); }
            return;
        }
        if (kind == 5) {
            const bool first = (u.pm & (SEQ - 1)) == 0;
            if (!first && wr == 0 && fr < 2) {
#pragma unroll
                for (int bj = 0; bj < 2; ++bj) { const f32x4 b0 = acc[0][bj][0][0], b1 = acc[0][bj][0][1];
                    u32x4 wb; wb.x = cvt_pk_bf16(b0[0], b0[1]); wb.y = cvt_pk_bf16(b0[2], b0[3]); wb.z = cvt_pk_bf16(b1[0], b1[1]); wb.w = cvt_pk_bf16(b1[2], b1[3]);
                    *(u32x4*)((char*)base + (WS_BGE - WS_PROJ) + (unsigned)(((u.pm >> 8) * 2 + fr) * CW + col0 + bj * HALF) * 2u) = wb; } }
#define P1_ROR(x, n) (unsigned)__builtin_amdgcn_update_dpp(0, (int)(x), 0x120 + (n), 0xf, 0xf, false)
#pragma unroll
            for (int bj = 0; bj < 2; ++bj) { const int ch = col0 + bj * HALF;
                const f32x4 k0a = *(const f32x4*)(conv_w + ch), k0b = *(const f32x4*)(conv_w + ch + 4), k1a = *(const f32x4*)(conv_w + CW + ch), k1b = *(const f32x4*)(conv_w + CW + ch + 4),
                            k2a = *(const f32x4*)(conv_w + 2 * CW + ch), k2b = *(const f32x4*)(conv_w + 2 * CW + ch + 4);
                u32x4 U[2][5];
#pragma unroll
                for (int ai = 0; ai < 2; ++ai)
#pragma unroll
                    for (int j = 0; j < 5; ++j) { const int row = row0 + ai * HALF + (j - 1) * 16;
                        U[ai][j] = *(const u32x4*)((const char*)base + (unsigned)((row >= 0 ? row : 0) * PJ + PC_V + ch) * 2u); }
#pragma unroll
                for (int ai = 0; ai < 2; ++ai)
#pragma unroll
                    for (int m = 0; m < 4; ++m) { const int row = row0 + ai * HALF + m * 16, t = row & (SEQ - 1), lr = ai * HALF + wr * 64 + m * 16 + fr;
                        u32x4 q1, q2;
#pragma unroll
                        for (int d = 0; d < 4; ++d) { const unsigned cu = U[ai][m + 1][d], pv = U[ai][m][d];
                            const unsigned c1 = P1_ROR(cu, 1), p1 = P1_ROR(pv, 1), c2 = P1_ROR(cu, 2), p2 = P1_ROR(pv, 2);
                            q1[d] = t >= 1 ? (fr >= 1 ? c1 : p1) : 0u; q2[d] = t >= 2 ? (fr >= 2 ? c2 : p2) : 0u; }
                        float a0[8], a1[8], a2[8]; unpack8(U[ai][m + 1], a0); unpack8(q1, a1); unpack8(q2, a2);
                        f32x4 v0 = acc[ai][bj][m][0], v1 = acc[ai][bj][m][1];
#pragma unroll
                        for (int e = 0; e < 4; ++e) { v0[e] *= k2a[e] * a0[e] + k1a[e] * a1[e] + k0a[e] * a2[e]; v1[e] *= k2b[e] * a0[4 + e] + k1b[e] * a1[4 + e] + k0b[e] * a2[4 + e]; }
                        u32x4 w; w.x = cvt_pk_bf16(v0[0], v0[1]); w.y = cvt_pk_bf16(v0[2], v0[3]); w.z = cvt_pk_bf16(v1[0], v1[1]); w.w = cvt_pk_bf16(v1[2], v1[3]);
                        if (first || lr >= 2) *(u32x4*)((char*)base + (unsigned)(row * PJ + ch) * 2u) = w; }
                asm volatile("" ::: "memory"); }
#undef P1_ROR
            return;
        }
        if (kind >= 2) {
            PG8_LAS float* X = (PG8_LAS float*)(lds + XCH_OFF);
#pragma unroll
            for (int ai = 0; ai < 2; ++ai)
#pragma unroll
                for (int m = 0; m < 4; ++m)
#pragma unroll
                    for (int bj = 0; bj < 2; ++bj) { const f32x4 v0 = acc[ai][bj][m][0], v1 = acc[ai][bj][m][1];
                        float s = (v0[0] * v0[0] + v0[1] * v0[1]) + (v0[2] * v0[2] + v0[3] * v0[3]) + (v1[0] * v1[0] + v1[1] * v1[1]) + (v1[2] * v1[2] + v1[3] * v1[3]);
                        s += __shfl_xor(s, 16); s += __shfl_xor(s, 32);
                        if (fq == 0) X[((ai * HALF + wr * 64 + m * 16 + fr) * 2 + bj) * 4 + wc] = s; }
            asm volatile("s_waitcnt lgkmcnt(0)" ::: "memory"); __builtin_amdgcn_s_barrier(); asm volatile("" ::: "memory");
            const bool isq = u.pn < PC_FK / BM;
            const float inv = kind == 3 ? (1.f / MD) : (1.f / FD);
            f32x4 g[2][2];
            if (kind == 3) { const float* gp = u.seg == 1 ? mkg : mqg; const float sc = u.seg == 1 ? 1.f : C2M;
#pragma unroll
                for (int bj = 0; bj < 2; ++bj) { const int gi = bj * HALF + wc * 32 + 8 * fq; g[bj][0] = *(const f32x4*)(gp + gi) * sc; g[bj][1] = *(const f32x4*)(gp + gi + 4) * sc; }
            } else if (isq) {
                const int gi = wc * 32 + 8 * fq; g[0][0] = *(const f32x4*)(fqg + gi) * C2F; g[0][1] = *(const f32x4*)(fqg + gi + 4) * C2F; g[1][0] = g[0][0]; g[1][1] = g[0][1];
            } else {
                const int gi = wc * 32 + 8 * fq; g[0][0] = *(const f32x4*)(fkg + gi); g[0][1] = *(const f32x4*)(fkg + gi + 4); g[1][0] = g[0][0]; g[1][1] = g[0][1];
            }
#pragma unroll
            for (int ai = 0; ai < 2; ++ai)
#pragma unroll
                for (int m = 0; m < 4; ++m) { const int rl = ai * HALF + wr * 64 + m * 16 + fr;
                    const f32x4 t0 = *(PG8_LAS const f32x4*)(X + rl * 8), t1 = *(PG8_LAS const f32x4*)(X + rl * 8 + 4);
                    float s0 = (t0[0] + t0[1]) + (t0[2] + t0[3]), s1 = (t1[0] + t1[1]) + (t1[2] + t1[3]);
                    if (kind == 3) { s0 += s1; s1 = s0; }
                    const float r0 = rsqrtf(s0 * inv + EPS), r1 = rsqrtf(s1 * inv + EPS);
                    bf16_t* rowp = base + (size_t)(row0 + ai * HALF + m * 16) * ldc + col0;
#pragma unroll
                    for (int bj = 0; bj < 2; ++bj) { const float r = bj ? r1 : r0; const f32x4 v0 = acc[ai][bj][m][0] * g[bj][0] * r, v1 = acc[ai][bj][m][1] * g[bj][1] * r;
                        u32x4 w; w.x = cvt_pk_bf16(v0[0], v0[1]); w.y = cvt_pk_bf16(v0[2], v0[3]); w.z = cvt_pk_bf16(v1[0], v1[1]); w.w = cvt_pk_bf16(v1[2], v1[3]);
                        *(u32x4*)(rowp + bj * HALF) = w; } }
            return;
        }
        if (kind == 1) {
#pragma unroll
            for (int ai = 0; ai < 2; ++ai)
#pragma unroll
                for (int m = 0; m < 4; ++m)
#pragma unroll
                    for (int bj = 0; bj < 2; ++bj) { const f32x4 v0 = acc[ai][bj][m][0], v1 = acc[ai][bj][m][1]; unsigned q[8];
#pragma unroll
                        for (int e = 0; e < 4; ++e) { q[e] = (unsigned)fmaxf(255.f * __builtin_amdgcn_rcpf(1.f + __builtin_amdgcn_exp2f(-LOG2E * v0[e])) + 0.5f, 1.f); q[4 + e] = (unsigned)fmaxf(255.f * __builtin_amdgcn_rcpf(1.f + __builtin_amdgcn_exp2f(-LOG2E * v1[e])) + 0.5f, 1.f); }
                        u32x2 w; w.x = q[0] | (q[1] << 8) | (q[2] << 16) | (q[3] << 24); w.y = q[4] | (q[5] << 8) | (q[6] << 16) | (q[7] << 24);
                        *(u32x2*)(gates + (size_t)(row0 + ai * HALF + m * 16) * NG + col0 + bj * HALF) = w; }
            return;
        }
        const bool sig = false;
#pragma unroll
        for (int ai = 0; ai < 2; ++ai)
#pragma unroll
            for (int m = 0; m < 4; ++m) { bf16_t* rowp = base + (size_t)(row0 + ai * HALF + m * 16) * ldc + col0;
#pragma unroll
                for (int bj = 0; bj < 2; ++bj) { f32x4 v0 = acc[ai][bj][m][0], v1 = acc[ai][bj][m][1];
                    if (sig) {
#pragma unroll
                        for (int e = 0; e < 4; ++e) { v0[e] = __builtin_amdgcn_rcpf(1.f + __builtin_amdgcn_exp2f(-LOG2E * v0[e])); v1[e] = __builtin_amdgcn_rcpf(1.f + __builtin_amdgcn_exp2f(-LOG2E * v1[e])); } }
                    u32x4 w; w.x = cvt_pk_bf16(v0[0], v0[1]); w.y = cvt_pk_bf16(v0[2], v0[3]); w.z = cvt_pk_bf16(v1[0], v1[1]); w.w = cvt_pk_bf16(v1[2], v1[3]);
                    *(u32x4*)(rowp + bj * HALF) = w; } }
    } };
constexpr int P1_NTRI = BATCH * 16 * 4, P1_NPOOL = (M / BM) * ((NPACK - 3 * CW) / BM) + 16, P1_NUNITS = 3 * P1_NTRI + P1_NPOOL;
constexpr int P1_STATIC = 6, P1_NDEAL = 18;
struct SchedP1 { unsigned hb, W; int G, c; unsigned* rdy; unsigned xoff, nloc;
    static constexpr int READY_UNIT = 3;
    __device__ __forceinline__ void ready() const { if (threadIdx.x == 0) {
        const unsigned old = __hip_atomic_fetch_add(rdy - 4109 + xoff, 1u, __ATOMIC_RELAXED, __HIP_MEMORY_SCOPE_AGENT);
        if (old + 1u == nloc) { __builtin_amdgcn_fence(__ATOMIC_RELEASE, "agent"); (void)__hip_atomic_fetch_add(rdy, nloc, __ATOMIC_RELAXED, __HIP_MEMORY_SCOPE_AGENT); } } }
    __device__ __forceinline__ bool pool(int p, Unit& u) const {
        constexpr int nM = M / BM, nN = (NPACK - 3 * CW) / BM, NMAIN = nM * nN;
        if (p >= 16 + NMAIN) return false;
        if (p >= 16) { int pm, pn; tile_of(p - 16, nM, nN, pm, pn); u.pm = pm * BM; u.pn = pn + 3 * CW / BM; u.seg = 0; u.A = hb + (unsigned)u.pm * DM * 2; u.B = W + (unsigned)u.pn * BM * DM * 2; return true; }
        const int b = p >> 3, hm = p & 3;
        if ((p & 4) == 0) { u.seg = 1; u.pm = b * MT; u.pn = hm; u.A = hb + (unsigned)(M + b * MT) * DM * 2; u.B = W + (unsigned)(NPACK + hm * MD) * DM * 2; }
        else { u.seg = 2; u.pm = 0; u.pn = b * MH + hm; u.A = W + (unsigned)(NPACK + MH * MD + hm * MD) * DM * 2; u.B = hb + (unsigned)(M + b * MT) * DM * 2; }
        return true; }
    __device__ __forceinline__ bool next(int i, Unit& u) const {
        int p;
        if (i >= P1_STATIC) return false;
        if (i < 3) {
            if (c < P1_NTRI) {
                const int x = c & 7, y = c >> 3, q = 4 * x + (y >> 2), j = y & 3;
                u.pm = q * BM; u.pn = (i == 0 ? 4 : (i == 1 ? 8 : 0)) + j; u.seg = i == 0 ? 0 : 3 + i;
                u.A = hb + (unsigned)u.pm * DM * 2; u.B = W + (unsigned)u.pn * BM * DM * 2; return true; }
            p = i * (G - P1_NTRI) + (c - P1_NTRI);
        } else p = 3 * (G - P1_NTRI) + (i - 3) * G + c;
        return pool(p, u); } };

struct EpiMerge { const unsigned char* gates; bf16_t* merged;
    __device__ __forceinline__ void mid(Acc& acc, const Unit& u, int sg, int wr, int wc, int fr, int fq) const {
        asm volatile("" : "+v"(fr), "+v"(fq));
        const int row0 = u.pm * BM + wr * 64 + fr, col0 = u.pn * BM + wc * 32 + 8 * fq + (sg - 1) * DM;
#pragma unroll
        for (int ai = 0; ai < 2; ++ai) { u32x2 Ga[4][2], Gb[4][2];
#pragma unroll
            for (int m = 0; m < 4; ++m)
#pragma unroll
                for (int bj = 0; bj < 2; ++bj) { const unsigned char* gp = gates + (size_t)(row0 + ai * HALF + m * 16) * NG + col0 + bj * HALF; Ga[m][bj] = *(const u32x2*)gp; Gb[m][bj] = *(const u32x2*)(gp + DM); }
#pragma unroll
            for (int m = 0; m < 4; ++m)
#pragma unroll
                for (int bj = 0; bj < 2; ++bj)
#pragma unroll
                    for (int e = 0; e < 4; ++e) {
                        acc[ai][bj][m][0][e] *= (float)((Ga[m][bj].x >> (8 * e)) & 0xffu) * __builtin_amdgcn_rcpf((float)((Gb[m][bj].x >> (8 * e)) & 0xffu));
                        acc[ai][bj][m][1][e] *= (float)((Ga[m][bj].y >> (8 * e)) & 0xffu) * __builtin_amdgcn_rcpf((float)((Gb[m][bj].y >> (8 * e)) & 0xffu)); }
            asm volatile("" ::: "memory"); }
    }
    __device__ __forceinline__ void operator()(Acc& acc, const Unit& u, int wr, int wc, int fr, int fq, PG8_LAS unsigned char*) const {
        asm volatile("" : "+v"(fr), "+v"(fq));
        const int row0 = u.pm * BM + wr * 64 + fr, col0 = u.pn * BM + wc * 32 + 8 * fq;
        u32x2 G[2][4][2];
#pragma unroll
        for (int ai = 0; ai < 2; ++ai)
#pragma unroll
            for (int m = 0; m < 4; ++m)
#pragma unroll
                for (int bj = 0; bj < 2; ++bj) G[ai][m][bj] = *(const u32x2*)(gates + (size_t)(row0 + ai * HALF + m * 16) * NG + 2 * DM + col0 + bj * HALF);
#pragma unroll
        for (int ai = 0; ai < 2; ++ai)
#pragma unroll
            for (int m = 0; m < 4; ++m)
#pragma unroll
                for (int bj = 0; bj < 2; ++bj) { f32x4 v0 = acc[ai][bj][m][0], v1 = acc[ai][bj][m][1];
#pragma unroll
                    for (int e = 0; e < 4; ++e) { v0[e] *= (float)((G[ai][m][bj].x >> (8 * e)) & 0xffu) * (1.f / 255.f); v1[e] *= (float)((G[ai][m][bj].y >> (8 * e)) & 0xffu) * (1.f / 255.f); }
                    u32x4 w; w.x = cvt_pk_bf16(v0[0], v0[1]); w.y = cvt_pk_bf16(v0[2], v0[3]); w.z = cvt_pk_bf16(v1[0], v1[1]); w.w = cvt_pk_bf16(v1[2], v1[3]);
                    *(u32x4*)(merged + (size_t)(row0 + ai * HALF + m * 16) * DM + col0 + bj * HALF) = w; }
    } };

struct SchedG { unsigned A, B; int lda, ldb, nM, nN, G, c;
    __device__ __forceinline__ bool next(int i, Unit& u) const {
        const int L = i * G + c; if (L >= nM * nN) return false;
        tile_of(L, nM, nN, u.pm, u.pn); u.seg = 0; u.A = A + (unsigned)u.pm * BM * lda * 2; u.B = B + (unsigned)u.pn * BM * ldb * 2; return true; } };

struct EpiP4 { const float* rv; bf16_t* x1b; float* ssp;
    __device__ __forceinline__ void operator()(Acc& acc, const Unit& u, int wr, int wc, int fr, int fq, PG8_LAS unsigned char*) const {
        asm volatile("" : "+v"(fr), "+v"(fq));
        const int row0 = u.pm * BM + wr * 64 + fr, col0 = u.pn * BM + wc * 32 + 8 * fq;
#pragma unroll
        for (int ai = 0; ai < 2; ++ai) { u32x4 Hq[4][2]; float rr[4];
#pragma unroll
            for (int m = 0; m < 4; ++m) { const size_t row = (size_t)(row0 + ai * HALF + m * 16); rr[m] = rv[row];
#pragma unroll
                for (int bj = 0; bj < 2; ++bj) Hq[m][bj] = *(const u32x4*)(x1b + row * DM + col0 + bj * HALF); }
#pragma unroll
            for (int m = 0; m < 4; ++m) { const size_t row = (size_t)(row0 + ai * HALF + m * 16); float s = 0.f;
#pragma unroll
                for (int bj = 0; bj < 2; ++bj) { float h[8]; unpack8(Hq[m][bj], h);
                    f32x4 v0 = acc[ai][bj][m][0], v1 = acc[ai][bj][m][1];
#pragma unroll
                    for (int e = 0; e < 4; ++e) { v0[e] += h[e] * rr[m]; v1[e] += h[4 + e] * rr[m]; }
                    u32x4 w; w.x = cvt_pk_bf16(v0[0], v0[1]); w.y = cvt_pk_bf16(v0[2], v0[3]); w.z = cvt_pk_bf16(v1[0], v1[1]); w.w = cvt_pk_bf16(v1[2], v1[3]);
                    *(u32x4*)(x1b + row * DM + col0 + bj * HALF) = w;
                    s += (v0[0] * v0[0] + v0[1] * v0[1]) + (v0[2] * v0[2] + v0[3] * v0[3]) + (v1[0] * v1[0] + v1[1] * v1[1]) + (v1[2] * v1[2] + v1[3] * v1[3]); }
                s += __shfl_xor(s, 16); s += __shfl_xor(s, 32);
                if (fq == 0) ssp[row * 32 + u.pn * 4 + wc] = s; }
            asm volatile("" ::: "memory"); }
    } };
__device__ __forceinline__ void p5_rtable(const float* __restrict__ ssp, int pm, PG8_LAS unsigned char* lds) {
    int t = threadIdx.x; asm volatile("" : "+v"(t));
    PG8_LAS float* T = (PG8_LAS float*)(lds + XCH_OFF);
    if (t < BM) { const float* p = ssp + (size_t)(pm * BM + t) * 32; float s = 0.f;
#pragma unroll
        for (int j = 0; j < 8; ++j) { const f32x4 v = *(const f32x4*)(p + 4 * j); s += (v[0] + v[1]) + (v[2] + v[3]); }
        T[t] = rsqrtf(s * (1.f / DM) + EPS); }
    if (t == 0) *(PG8_LAS int*)(lds + XCH_OFF + 1024) = pm;
}
struct EpiP5 { const float* ssp; bf16_t* U;
    __device__ __forceinline__ void operator()(Acc& acc, const Unit& u, int wr, int wc, int fr, int fq, PG8_LAS unsigned char* lds) const {
        asm volatile("" : "+v"(fr), "+v"(fq));
        if (*(volatile PG8_LAS int*)(lds + XCH_OFF + 1024) != u.pm) {
            __builtin_amdgcn_s_barrier(); p5_rtable(ssp, u.pm, lds); asm volatile("s_waitcnt lgkmcnt(0)" ::: "memory"); __builtin_amdgcn_s_barrier(); }
        const PG8_LAS float* T = (const PG8_LAS float*)(lds + XCH_OFF);
        const int row0 = u.pm * BM + wr * 64 + fr, col0 = u.pn * BM + wc * 32 + 8 * fq;
#pragma unroll
        for (int ai = 0; ai < 2; ++ai)
#pragma unroll
            for (int m = 0; m < 4; ++m) { const size_t row = (size_t)(row0 + ai * HALF + m * 16);
                const float r = T[ai * HALF + wr * 64 + m * 16 + fr];
#pragma unroll
                for (int bj = 0; bj < 2; ++bj) { f32x4 v0 = acc[ai][bj][m][0] * r, v1 = acc[ai][bj][m][1] * r;
#pragma unroll
                    for (int e = 0; e < 4; ++e) { v0[e] = fmaxf(v0[e], 0.f); v0[e] *= v0[e]; v1[e] = fmaxf(v1[e], 0.f); v1[e] *= v1[e]; }
                    u32x4 w; w.x = cvt_pk_bf16(v0[0], v0[1]); w.y = cvt_pk_bf16(v0[2], v0[3]); w.z = cvt_pk_bf16(v1[0], v1[1]); w.w = cvt_pk_bf16(v1[2], v1[3]);
                    *(u32x4*)(U + row * DFF + col0 + bj * HALF) = w; } }
    } };
struct EpiP6 { float* out; const bf16_t* x1b;
    __device__ __forceinline__ void operator()(Acc& acc, const Unit& u, int wr, int wc, int fr, int fq, PG8_LAS unsigned char*) const {
        asm volatile("" : "+v"(fr), "+v"(fq));
        const int row0 = u.pm * BM + wr * 64 + fr, col0 = u.pn * BM + wc * 32 + 8 * fq;
#pragma unroll
        for (int ai = 0; ai < 2; ++ai) { u32x4 Tq[4][2];
#pragma unroll
            for (int m = 0; m < 4; ++m)
#pragma unroll
                for (int bj = 0; bj < 2; ++bj) Tq[m][bj] = *(const u32x4*)(x1b + (size_t)(row0 + ai * HALF + m * 16) * DM + col0 + bj * HALF);
#pragma unroll
            for (int m = 0; m < 4; ++m)
#pragma unroll
                for (int bj = 0; bj < 2; ++bj) { const size_t off = (size_t)(row0 + ai * HALF + m * 16) * DM + col0 + bj * HALF;
                    float t[8]; unpack8(Tq[m][bj], t);
                    f32x4 v0 = acc[ai][bj][m][0], v1 = acc[ai][bj][m][1];
#pragma unroll
                    for (int e = 0; e < 4; ++e) { v0[e] += t[e]; v1[e] += t[4 + e]; }
                    *(f32x4*)(out + off) = v0; *(f32x4*)(out + off + 4) = v1; }
            asm volatile("" ::: "memory"); }
    } };
struct EpiMemS { bf16_t* PM;
    __device__ __forceinline__ void operator()(Acc& acc, const Unit& u, int wr, int wc, int fr, int fq, PG8_LAS unsigned char* lds) const {
        PG8_LAS float* X1 = (PG8_LAS float*)(lds + XCH_OFF); PG8_LAS float* X2 = X1 + 1024;
#pragma unroll
        for (int ai = 0; ai < 2; ++ai)
#pragma unroll
            for (int m = 0; m < 4; ++m) { float v = -INFINITY;
#pragma unroll
                for (int bj = 0; bj < 2; ++bj)
#pragma unroll
                    for (int n = 0; n < 2; ++n)
#pragma unroll
                        for (int e = 0; e < 4; ++e) v = fmaxf(v, acc[ai][bj][m][n][e]);
                v = fmaxf(v, __shfl_xor(v, 16)); v = fmaxf(v, __shfl_xor(v, 32));
                if (fq == 0) X1[(ai * HALF + wr * 64 + m * 16 + fr) * 4 + wc] = v; }
        asm volatile("s_waitcnt lgkmcnt(0)" ::: "memory"); __builtin_amdgcn_s_barrier(); asm volatile("" ::: "memory");
#pragma unroll
        for (int ai = 0; ai < 2; ++ai)
#pragma unroll
            for (int m = 0; m < 4; ++m) { const int rl = ai * HALF + wr * 64 + m * 16 + fr;
                const f32x4 t = *(PG8_LAS const f32x4*)(X1 + rl * 4); const float mx = fmaxf(fmaxf(t[0], t[1]), fmaxf(t[2], t[3]));
                float s = 0.f;
#pragma unroll
                for (int bj = 0; bj < 2; ++bj)
#pragma unroll
                    for (int n = 0; n < 2; ++n)
#pragma unroll
                        for (int e = 0; e < 4; ++e) { const float p = __builtin_amdgcn_exp2f(acc[ai][bj][m][n][e] - mx); acc[ai][bj][m][n][e] = p; s += p; }
                s += __shfl_xor(s, 16); s += __shfl_xor(s, 32);
                if (fq == 0) X2[rl * 4 + wc] = s; }
        asm volatile("s_waitcnt lgkmcnt(0)" ::: "memory"); __builtin_amdgcn_s_barrier(); asm volatile("" ::: "memory");
        const int row0 = u.pm * BM, col0 = u.seg * MT + wc * 32 + 8 * fq;
#pragma unroll
        for (int ai = 0; ai < 2; ++ai)
#pragma unroll
            for (int m = 0; m < 4; ++m) { const int rl = ai * HALF + wr * 64 + m * 16 + fr;
                const f32x4 t = *(PG8_LAS const f32x4*)(X2 + rl * 4); const float r = 1.f / ((t[0] + t[1]) + (t[2] + t[3]));
#pragma unroll
                for (int bj = 0; bj < 2; ++bj) { const f32x4 v0 = acc[ai][bj][m][0] * r, v1 = acc[ai][bj][m][1] * r;
                    u32x4 w; w.x = cvt_pk_bf16(v0[0], v0[1]); w.y = cvt_pk_bf16(v0[2], v0[3]); w.z = cvt_pk_bf16(v1[0], v1[1]); w.w = cvt_pk_bf16(v1[2], v1[3]);
                    *(u32x4*)(PM + (size_t)(row0 + rl) * 1024 + col0 + bj * HALF) = w; } }
    } };
struct EpiPlain { bf16_t* base; int ldc;
    __device__ __forceinline__ void operator()(Acc& acc, const Unit& u, int wr, int wc, int fr, int fq, PG8_LAS unsigned char*) const {
        const int row0 = u.pm * BM + wr * 64 + fr, col0 = u.pn * BM + wc * 32 + 8 * fq;
#pragma unroll
        for (int ai = 0; ai < 2; ++ai)
#pragma unroll
            for (int m = 0; m < 4; ++m) { bf16_t* rowp = base + (size_t)(row0 + ai * HALF + m * 16) * ldc + col0;
#pragma unroll
                for (int bj = 0; bj < 2; ++bj) { const f32x4 v0 = acc[ai][bj][m][0], v1 = acc[ai][bj][m][1];
                    u32x4 w; w.x = cvt_pk_bf16(v0[0], v0[1]); w.y = cvt_pk_bf16(v0[2], v0[3]); w.z = cvt_pk_bf16(v1[0], v1[1]); w.w = cvt_pk_bf16(v1[2], v1[3]);
                    *(u32x4*)(rowp + bj * HALF) = w; } }
    } };
struct SchedOne { Unit u; __device__ __forceinline__ bool next(int i, Unit& o) const { if (i) return false; o = u; return true; } };
}


namespace fox {
#define FLAS __attribute__((address_space(3)))
constexpr int NW = 8, QBLK = 32, KVBLK = 64, QB = NW * QBLK, D = 128;
constexpr int SHM_V = KVBLK * D * 2, SHM_K = KVBLK * D * 2;
constexpr int OFF_V = 0, OFF_K = 2 * SHM_V, OFF_WS = OFF_K + 2 * SHM_K, OFF_C = OFF_WS + NW * 64 * 4, LDS_NEED = OFF_C + SEQ * 4;
constexpr float THR2 = 8.f * LOG2E;
#define KSWZ(row, colB) ((row) * 256 + ((colB) ^ (((row) & 7) << 4)))
#define SBAR() __builtin_amdgcn_sched_barrier(0)
__device__ __forceinline__ int v_st(int k, int c) { const int kk = (k & ~0xC) | ((k & 4) << 1) | ((k & 8) >> 1); return ((kk >> 3) * 4 + (c >> 5)) * 512 + ((kk & 7) * 32 + (c & 31)) * 2; }
__device__ __forceinline__ int v_rd_base(int lane) { return ((lane & 3) << 3) | (((lane >> 2) & 3) << 6) | (((lane >> 4) & 1) << 5) | (((lane >> 5) & 1) << 8); }
constexpr int v_rd_off(int d0, int ks, int half) { return d0 * 512 + ks * 4096 + half * 2048; }
__device__ __forceinline__ int crow(int r, int hi) { return (r & 3) + 8 * (r >> 2) + 4 * hi; }
__device__ __forceinline__ unsigned cvtpk(float lo, float hi) { unsigned r; asm volatile("v_cvt_pk_bf16_f32 %0, %1, %2" : "=v"(r) : "v"(lo), "v"(hi)); return r; }
typedef short s16x4 __attribute__((ext_vector_type(4)));
__device__ __forceinline__ void mask_tile(f32x16& p0, f32x16& p1, int dq) {
    const float NEG = -__builtin_inff();
#pragma unroll
    for (int r = 0; r < 16; ++r) { const int c = (r & 3) + 8 * (r >> 2); if (dq - c < 0) p0[r] = NEG; if (dq - c - 32 < 0) p1[r] = NEG; }
}
__device__ __forceinline__ void partialSM(f32x16& p0, f32x16& p1, float& m_reg, float& mn, float& alpha) {
    float pmax = p0[0];
#pragma unroll
    for (int r = 1; r < 16; ++r) pmax = fmaxf(pmax, p0[r]);
#pragma unroll
    for (int r = 0; r < 16; ++r) pmax = fmaxf(pmax, p1[r]);
    { auto rr = __builtin_amdgcn_permlane32_swap(__float_as_uint(pmax), __float_as_uint(pmax), false, false);
      pmax = fmaxf(__uint_as_float(rr[0]), __uint_as_float(rr[1])); }
    if (__builtin_expect(__all((pmax - m_reg) <= THR2), 1)) { mn = m_reg; alpha = 1.f; }
    else { mn = fmaxf(m_reg, pmax); alpha = __builtin_amdgcn_exp2f(m_reg - mn); m_reg = mn; }
#pragma unroll
    for (int r = 0; r < 16; ++r) p0[r] = p0[r] - mn;
#pragma unroll
    for (int r = 0; r < 16; ++r) p1[r] = p1[r] - mn;
#pragma unroll
    for (int r = 0; r < 16; ++r) p0[r] = __builtin_amdgcn_exp2f(p0[r]);
}
__device__ __forceinline__ void finishSM(f32x16& p0, f32x16& p1, float alpha, float& l_reg, bf16x8& pa0, bf16x8& pa1, bf16x8& pa2, bf16x8& pa3) {
#pragma unroll
    for (int r = 0; r < 16; ++r) p1[r] = __builtin_amdgcn_exp2f(p1[r]);
    float ps = 0;
#pragma unroll
    for (int r = 0; r < 16; ++r) ps += p0[r];
#pragma unroll
    for (int r = 0; r < 16; ++r) ps += p1[r];
    { auto rr = __builtin_amdgcn_permlane32_swap(__float_as_uint(ps), __float_as_uint(ps), false, false);
      ps = __uint_as_float(rr[0]) + __uint_as_float(rr[1]); }
    l_reg = l_reg * alpha + ps;
#define PK4(P, B_, OUT) do { unsigned a0 = cvtpk(P[B_+0], P[B_+1]), a1 = cvtpk(P[B_+2], P[B_+3]);                          \
        unsigned b0 = cvtpk(P[B_+4], P[B_+5]), b1 = cvtpk(P[B_+6], P[B_+7]);                                             \
        auto r0 = __builtin_amdgcn_permlane32_swap(a0, b0, false, false); auto r1 = __builtin_amdgcn_permlane32_swap(a1, b1, false, false); \
        u32x4 w = {r0[0], r1[0], r0[1], r1[1]}; OUT = __builtin_bit_cast(bf16x8, w); } while (0)
    PK4(p0, 0, pa0); PK4(p0, 8, pa1); PK4(p1, 0, pa2); PK4(p1, 8, pa3);
#undef PK4
}
template <int KB>
__device__ __forceinline__ void qkt(f32x16& p0, f32x16& p1, FLAS const char* K_lds, FLAS const float* ctile, int r32, int hi, const bf16x8* qr) {
    FLAS const float* cl = ctile + 4 * hi;
#pragma unroll
    for (int g = 0; g < 4; ++g) { const f32x4 a = *(FLAS const f32x4*)(cl + 8 * g), b = *(FLAS const f32x4*)(cl + 32 + 8 * g);
#pragma unroll
        for (int e = 0; e < 4; ++e) { p0[4 * g + e] = a[e]; p1[4 * g + e] = b[e]; } }
    FLAS const char* kb[4];
#pragma unroll
    for (int dd = 0; dd < 4; ++dd) kb[dd] = K_lds + KB * SHM_K + KSWZ(r32, (dd * 16 + hi * 8) * 2);
#pragma unroll
    for (int d0 = 0; d0 < 8; ++d0) { FLAS const char* a = kb[d0 & 3] + (d0 >> 2) * 128;
        const bf16x8 b0 = *(FLAS const bf16x8*)(a);
        const bf16x8 b1 = *(FLAS const bf16x8*)(a + 32 * 256);
        p0 = __builtin_amdgcn_mfma_f32_32x32x16_bf16(b0, qr[d0], p0, 0, 0, 0);
        p1 = __builtin_amdgcn_mfma_f32_32x32x16_bf16(b1, qr[d0], p1, 0, 0, 0); }
}
template <int VB>
__device__ __forceinline__ void pv_tile(f32x16* o, int vb0, bf16x8 pa0, bf16x8 pa1, bf16x8 pa2, bf16x8 pa3) {
#define TRRD(dst, off) asm volatile("ds_read_b64_tr_b16 %0, %1 offset:%2" : "=&v"(dst) : "v"(vb0), "i"(off) : "memory")
#define PV_D0(d0) do { s16x4 l0, l1, l2, l3, h0, h1, h2, h3; constexpr int b_ = OFF_V + VB * SHM_V + v_rd_off(d0, 0, 0); \
        TRRD(l0, b_); TRRD(h0, b_ + 2048); TRRD(l1, b_ + 4096); TRRD(h1, b_ + 6144); TRRD(l2, b_ + 8192); TRRD(h2, b_ + 10240); TRRD(l3, b_ + 12288); TRRD(h3, b_ + 14336); \
        asm volatile("s_waitcnt lgkmcnt(0)" ::: "memory"); SBAR();   \
        o[d0] = __builtin_amdgcn_mfma_f32_32x32x16_bf16(pa0, (bf16x8){l0[0], l0[1], l0[2], l0[3], h0[0], h0[1], h0[2], h0[3]}, o[d0], 0, 0, 0);   \
        o[d0] = __builtin_amdgcn_mfma_f32_32x32x16_bf16(pa1, (bf16x8){l1[0], l1[1], l1[2], l1[3], h1[0], h1[1], h1[2], h1[3]}, o[d0], 0, 0, 0);   \
        o[d0] = __builtin_amdgcn_mfma_f32_32x32x16_bf16(pa2, (bf16x8){l2[0], l2[1], l2[2], l2[3], h2[0], h2[1], h2[2], h2[3]}, o[d0], 0, 0, 0);   \
        o[d0] = __builtin_amdgcn_mfma_f32_32x32x16_bf16(pa3, (bf16x8){l3[0], l3[1], l3[2], l3[3], h3[0], h3[1], h3[2], h3[3]}, o[d0], 0, 0, 0); } while (0)
    PV_D0(0); PV_D0(1); PV_D0(2); PV_D0(3);
#undef PV_D0
#undef TRRD
}
struct BlockRef { bf16_t* base; int P0; };
struct Seam { bf16x8 qr[8]; bf16x8 st_v0, st_v1, st_k0, st_k1; };
#define VMW() asm volatile("s_waitcnt vmcnt(0)" ::: "memory")
#define VMWN(n) asm volatile("s_waitcnt vmcnt(%0)" :: "i"(n) : "memory")
#define LD8(p) (*(const bf16x8*)(p))
#define FRESH(t_) int t_ = threadIdx.x; asm volatile("" : "+v"(t_))
#define SLOAD_H(Bp, k0) do { FRESH(t_); const unsigned toff_ = (unsigned)((t_ >> 4) * PJ + (t_ & 15) * 8); const bf16_t* tk_ = (Bp) + PC_FK + (size_t)(k0) * PJ; const bf16_t* tv_ = (Bp) + PC_FV + (size_t)(k0) * PJ; \
        S.st_v0 = LD8(tv_ + toff_); S.st_v1 = LD8(tv_ + 32 * PJ + toff_); S.st_k0 = LD8(tk_ + toff_); S.st_k1 = LD8(tk_ + 32 * PJ + toff_); } while (0)
#define SWRITE_HK(bf) do { FRESH(t_); const int kws_ = KSWZ(t_ >> 4, (t_ & 15) * 16); *(FLAS bf16x8*)(K_lds + (bf) * SHM_K + kws_) = S.st_k0; *(FLAS bf16x8*)(K_lds + (bf) * SHM_K + kws_ + 32 * 256) = S.st_k1; } while (0)
#define SWRITE_HV(bf) do { FRESH(t_); const int vst0_ = v_st(t_ >> 4, (t_ & 15) * 8), vst1_ = v_st(32 + (t_ >> 4), (t_ & 15) * 8); *(FLAS bf16x8*)(V_lds + (bf) * SHM_V + vst0_) = S.st_v0; *(FLAS bf16x8*)(V_lds + (bf) * SHM_V + vst1_) = S.st_v1; } while (0)
#define SWRITE_H(bf) do { SWRITE_HV(bf); SWRITE_HK(bf); } while (0)
__device__ __forceinline__ int prime(const BlockRef& cur, const float* nck, const float* fqg, const float* fkg, FLAS char* lds, Seam& S) {
    int tid_ = threadIdx.x; asm volatile("" : "+v"(tid_));
    const int tid = tid_, wid = __builtin_amdgcn_readfirstlane(tid >> 6), lane = tid & 63, r32 = lane & 31, hi = lane >> 5;
    FLAS char* K_lds = lds + OFF_K; FLAS float* C_lds = (FLAS float*)(lds + OFF_C);
    const unsigned qoff = (unsigned)(r32 * PJ + hi * 8);
    { const f32x4 c0 = *(const f32x4*)(nck + 4 * tid), c1 = *(const f32x4*)(nck + 2048 + 4 * tid); *(FLAS f32x4*)(C_lds + 4 * tid) = c0; *(FLAS f32x4*)(C_lds + 2048 + 4 * tid) = c1; }
#pragma unroll
    for (int d0 = 0; d0 < 8; ++d0) S.qr[d0] = LD8(cur.base + PC_FQ + (size_t)(cur.P0 + wid * QBLK) * PJ + d0 * 16 + qoff);
    __syncthreads();
    const float gq = fmaxf(fabsf(fqg[lane]), fabsf(fqg[lane + 64])), gk = fmaxf(fabsf(fkg[lane]), fabsf(fkg[lane + 64]));
    const float thresh = 2.f * (1.02f * C2F * FD * wave_max(gq) * wave_max(gk)) + 40.f;
    const float cP0 = C_lds[cur.P0], ct = C_lds[64 * lane + 63];
    const int j_lo = __builtin_amdgcn_readfirstlane(__popcll(__ballot(cP0 - ct > thresh)));
    SLOAD_H(cur.base, j_lo * KVBLK); VMW(); SWRITE_HK(0);
    __syncthreads();
    return j_lo;
}
__device__ __forceinline__ void block(const BlockRef& cur, const int j_lo, FLAS char* lds, Seam& S) {
    int tid_ = threadIdx.x; asm volatile("" : "+v"(tid_));
    const int tid = tid_, wid = __builtin_amdgcn_readfirstlane(tid >> 6), lane = tid & 63, r32 = lane & 31, hi = lane >> 5;
    const int NT = cur.P0 / KVBLK + 4 - j_lo;
    const int qlo = cur.P0 + wid * QBLK;
    FLAS char* V_lds = lds + OFF_V; FLAS char* K_lds = lds + OFF_K; FLAS float* C_lds = (FLAS float*)(lds + OFF_C);
    FLAS float* ws = (FLAS float*)(lds + OFF_WS) + wid * 64; FLAS float* li_l = ws; FLAS float* al_l = ws + 32;
    float m_reg = -1e30f, l_reg = 0; f32x16 o[4] = {};
    const bf16_t* Bh = cur.base;
#define RESC(a) do { if (__any((a) < 1.f)) { if (hi == 0) al_l[r32] = (a); asm volatile("s_waitcnt lgkmcnt(0)" ::: "memory");              \
                     _Pragma("unroll") for (int d_ = 0; d_ < 4; ++d_) _Pragma("unroll") for (int r = 0; r < 16; ++r) o[d_][r] *= al_l[crow(r, hi)]; } } while (0)
#define KBASE(t) ((j_lo + (t)) * KVBLK)
#define MASKT(P0_, P1_, t) do { const int kb_ = KBASE(t); if (kb_ + KVBLK - 1 > qlo) { FRESH(tm_); mask_tile(P0_, P1_, qlo + (tm_ & 31) - 4 * ((tm_ >> 5) & 1) - kb_); } } while (0)
#define VB0() ({ FRESH(tv_); (int)(uintptr_t)lds + v_rd_base(tv_ & 63); })
    f32x16 pA0, pA1, pB0, pB1; float mnA, mnB, alA, alB; bf16x8 pa0, pa1, pa2, pa3;
    SWRITE_HV(0); SBAR();
    if (NT > 1) { SLOAD_H(Bh, KBASE(1)); }
    SBAR(); qkt<0>(pA0, pA1, K_lds, C_lds + KBASE(0), r32, hi, S.qr);
    MASKT(pA0, pA1, 0); partialSM(pA0, pA1, m_reg, mnA, alA);
    if (NT > 1) { VMW(); SWRITE_H(1); }
    __syncthreads();
#define HALF_STEP(PX0, PX1, mnX, alX, PY0, PY1, alY, t, KB, VB, SB) do {                                                      \
        SBAR(); qkt<KB>(PX0, PX1, K_lds, C_lds + KBASE(t), r32, hi, S.qr);                                                    \
        finishSM(PY0, PY1, alY, l_reg, pa0, pa1, pa2, pa3); SBAR();                                                           \
        if ((t) + 1 < NT) { SLOAD_H(Bh, KBASE((t) + 1)); SBAR(); }                                                            \
        pv_tile<VB>(o, VB0(), pa0, pa1, pa2, pa3); MASKT(PX0, PX1, (t)); partialSM(PX0, PX1, m_reg, mnX, alX);                   \
        __syncthreads();                                                                                                      \
        if ((t) + 1 < NT) { VMW(); SWRITE_H(SB); }                                                                            \
        RESC(alX); __syncthreads(); } while (0)
    for (int t = 1; t + 1 < NT; t += 2) {
        HALF_STEP(pB0, pB1, mnB, alB, pA0, pA1, alA, t, 1, 0, 0);
        HALF_STEP(pA0, pA1, mnA, alA, pB0, pB1, alB, t + 1, 0, 1, 1);
    }
    const bool even = (NT & 1) == 0;
    if (even) { SBAR(); qkt<1>(pB0, pB1, K_lds, C_lds + KBASE(NT - 1), r32, hi, S.qr); SBAR(); }
    finishSM(pA0, pA1, alA, l_reg, pa0, pa1, pa2, pa3); SBAR();
    pv_tile<0>(o, VB0(), pa0, pa1, pa2, pa3);
    if (even) { MASKT(pB0, pB1, NT - 1); partialSM(pB0, pB1, m_reg, mnB, alB); __syncthreads(); RESC(alB);
        finishSM(pB0, pB1, alB, l_reg, pa0, pa1, pa2, pa3); SBAR(); pv_tile<1>(o, VB0(), pa0, pa1, pa2, pa3); }
    if (hi == 0) li_l[r32] = l_reg; asm volatile("s_waitcnt lgkmcnt(0)" ::: "memory");
    float rli[16];
#pragma unroll
    for (int r = 0; r < 16; ++r) rli[r] = __builtin_amdgcn_rcpf(li_l[crow(r, hi)]);
    bf16_t* Ow = cur.base + PC_FQ + (size_t)(cur.P0 + wid * QBLK) * PJ;
    FLAS char* st = lds + LDS_NEED + wid * (16 * 272);
    FRESH(te_);
#pragma unroll
    for (int ps = 0; ps < 2; ++ps) {
#pragma unroll
        for (int r8 = 0; r8 < 8; ++r8) { const int r = ps * 8 + r8, lrow = crow(r, hi) - 16 * ps;
#pragma unroll
            for (int d0 = 0; d0 < 4; ++d0) { const float v = o[d0][r] * rli[r]; *(FLAS bf16_t*)(st + lrow * 272 + (d0 * 32 + r32) * 2) = (bf16_t)(cvtpk(v, v) & 0xffffu); } }
        asm volatile("s_waitcnt lgkmcnt(0)" ::: "memory");
        u32x4 w[4];
#pragma unroll
        for (int i = 0; i < 4; ++i) w[i] = *(FLAS const u32x4*)(st + (((te_ & 63) >> 4) + 4 * i) * 272 + (te_ & 15) * 16);
        asm volatile("s_waitcnt lgkmcnt(0)" ::: "memory");
#pragma unroll
        for (int i = 0; i < 4; ++i) *(u32x4*)(Ow + (unsigned)((16 * ps + ((te_ & 63) >> 4) + 4 * i) * PJ + (te_ & 15) * 8)) = w[i];
    }
    __syncthreads();
#undef RESC
#undef KBASE
#undef MASKT
#undef VB0
#undef HALF_STEP
}
#undef VMW
#undef VMWN
#undef LD8
#undef SLOAD_H
#undef SWRITE_HK
#undef SWRITE_HV
#undef SWRITE_H
#undef FRESH
#undef SBAR
#undef KSWZ
__device__ __forceinline__ void phase_item(FLAS char* lds, bf16_t* proj, const float* nck, const float* fqg, const float* fkg, int bh, int qb) {
    Seam S;
    const BlockRef cur{proj + (size_t)(bh >> 3) * SEQ * PJ + (bh & 7) * FD, qb * QB};
    const int j_lo = prime(cur, nck + (size_t)bh * SEQ, fqg, fkg, lds, S);
    block(cur, j_lo, lds, S);
}
}

constexpr int UP_SPLIT = 13 * (DFF / 64);
constexpr int NWAVES = 8, LDS_BYTES = 147456, RING_BYTES = 131072, MISC_OFF = RING_BYTES + 320;
#define GAS __attribute__((address_space(1)))
#define LAS __attribute__((address_space(3)))
#define XB_TMO      128
#define XB_XCNT(j)  (256  + 64 * (j))
#define XB_XSUB(j)  (1280 + 64 * (j))
#define XB_XGEN(j)  (2304 + 64 * (j))
#define XB_TOP      3328
#define XB_TOPGEN   3392
#define XCD_BAR_WORDS 3456
#define XB_SPIN_CAP (1u << 18)
#define XB_NONCANON 3520
#define XB_P4DONE 3584
#define XB_LCNT(k, j) (5120 + 64 * (32 * (k) + (j)))
__device__ __forceinline__ unsigned xb_ld(unsigned* p)              { return __hip_atomic_load(p, __ATOMIC_RELAXED, __HIP_MEMORY_SCOPE_AGENT); }
__device__ __forceinline__ unsigned xb_add(unsigned* p, unsigned v) { return __hip_atomic_fetch_add(p, v, __ATOMIC_RELAXED, __HIP_MEMORY_SCOPE_AGENT); }
__device__ __forceinline__ unsigned xb_xcc_id() { return (unsigned)__builtin_amdgcn_s_getreg((3 << 11) | 20) & 0xFu; }
#define XB_SPIN(cond, bar) do { unsigned _sp = 0; while (cond) { __builtin_amdgcn_s_sleep(6); \
    if ((++_sp & 255u) == 0u) { if (xb_ld(&(bar)[XB_TMO])) break; if (_sp > XB_SPIN_CAP) { atomicAdd(&(bar)[XB_TMO], 1u); break; } } } } while (0)
struct XcdBarrier { unsigned* bar; unsigned x; volatile LAS unsigned* st; };
__device__ __forceinline__ XcdBarrier xcd_barrier_post(unsigned* bar, volatile LAS unsigned* st) {
    XcdBarrier b; b.bar = bar; b.x = xb_xcc_id(); b.st = st;
    if (threadIdx.x == 0) { (void)xb_add(&bar[XB_XCNT(b.x)], 1u); if (b.x != (blockIdx.x & 7u)) (void)xb_add(&bar[XB_NONCANON], 1u); }
    return b;
}
__device__ __forceinline__ void xcd_barrier_complete(unsigned* bar, unsigned x, unsigned& nloc, unsigned& nx) {
    const unsigned G = gridDim.x * gridDim.y * gridDim.z;
    unsigned sum, cnt, mine, sp = 0u;
    for (;;) {
        sum = 0u; cnt = 0u; mine = 0u;
#pragma unroll
        for (unsigned j = 0; j < 16; ++j) { const unsigned c = xb_ld(&bar[XB_XCNT(j)]); sum += c; cnt += (c > 0u) ? 1u : 0u; mine = (j == x) ? c : mine; }
        if (sum == G) break;
        __builtin_amdgcn_s_sleep(1);
        if ((++sp & 255u) == 0u) { if (xb_ld(&bar[XB_TMO])) break; if (sp > XB_SPIN_CAP) { atomicAdd(&bar[XB_TMO], 1u); break; } }
    }
    nloc = mine > 0u ? mine : 1u; nx = cnt > 0u ? cnt : 1u;
}
__device__ __forceinline__ void xcd_barrier(const XcdBarrier& b) {
    asm volatile("s_waitcnt vmcnt(0)" ::: "memory");
    __syncthreads();
    if (threadIdx.x == 0) {
        unsigned* bar = b.bar;
        __builtin_amdgcn_s_waitcnt(0);
        unsigned nloc = b.st[0], nx = b.st[1];
        if (nloc == 0u) { xcd_barrier_complete(bar, b.x, nloc, nx); b.st[0] = nloc; b.st[1] = nx; }
        const unsigned old = xb_add(&bar[XB_XSUB(b.x)], 1u);
        const unsigned gen = old / nloc;
        if (old + 1u == (gen + 1u) * nloc) {
            __builtin_amdgcn_fence(__ATOMIC_RELEASE, "agent");
            asm volatile("s_waitcnt vmcnt(0)" ::: "memory");
            const unsigned og = xb_add(&bar[XB_TOP], 1u);
            const unsigned tg = og / nx;
            if (og + 1u == (tg + 1u) * nx) xb_add(&bar[XB_TOPGEN], 1u);
            else XB_SPIN(xb_ld(&bar[XB_TOPGEN]) == tg, bar);
            __builtin_amdgcn_fence(__ATOMIC_ACQUIRE, "agent");
            xb_add(&bar[XB_XGEN(b.x)], 1u);
            asm volatile("s_waitcnt vmcnt(0)" ::: "memory");
        } else {
            XB_SPIN(xb_ld(&bar[XB_XGEN(b.x)]) == gen, bar);
            __builtin_amdgcn_fence(__ATOMIC_ACQUIRE, "agent");
            asm volatile("s_waitcnt vmcnt(0)" ::: "memory");
        }
    }
    __syncthreads();
}

__device__ __forceinline__ void xcd_local_barrier(const XcdBarrier& b, int k) {
    asm volatile("s_waitcnt vmcnt(0)" ::: "memory");
    __syncthreads();
    if (threadIdx.x == 0) {
        const unsigned pid = 4u * (blockIdx.x & 7u) + ((blockIdx.x >> 3) & 3u);
        unsigned* cnt = &b.bar[XB_LCNT(k, pid)];
        if (k == 0) (void)xb_add(&b.bar[XB_P4DONE], 1u);
        (void)xb_add(cnt, 1u);
        XB_SPIN(xb_ld(cnt) < 8u, b.bar);
        __builtin_amdgcn_fence(__ATOMIC_ACQUIRE, "agent");
        asm volatile("s_waitcnt vmcnt(0)" ::: "memory");
    }
    __syncthreads();
}

struct TrRegs { f32x4 v[16]; };
__device__ __forceinline__ void p0_tr_load(TrRegs& R, const float* __restrict__ W, int ldw, int nblk, int remap, int item, int lane) {
    const int kb = item / nblk, nb = item - kb * nblk, k0 = 64 * kb, n0 = 64 * nb;
    const int src0 = n0 + ((remap && n0 >= OC_FL) ? 8 : 0);
    const int kr = lane >> 4, nc = (lane & 15) * 4;
    const float* wp = W + (size_t)(k0 + 2 * kr) * ldw + src0 + nc;
#pragma unroll
    for (int i = 0; i < 8; ++i) { R.v[2 * i] = __builtin_nontemporal_load((const f32x4*)(wp + (size_t)(8 * i) * ldw)); R.v[2 * i + 1] = __builtin_nontemporal_load((const f32x4*)(wp + (size_t)(8 * i + 1) * ldw)); }
}
template <bool NT = false>
__device__ __forceinline__ void p0_tr_store(const TrRegs& R, int K, int nblk, const float* __restrict__ g, bf16_t* __restrict__ WT, int row_off, LAS unsigned* scr, int item, int lane) {
    const int kb = item / nblk, nb = item - kb * nblk, k0 = 64 * kb, n0 = 64 * nb;
    const int kr = lane >> 4, nc = (lane & 15) * 4;
#pragma unroll
    for (int i = 0; i < 8; ++i) {
        float g0 = 1.f, g1 = 1.f; if (g) { g0 = g[k0 + 8 * i + 2 * kr]; g1 = g[k0 + 8 * i + 2 * kr + 1]; }
        const int kp = 4 * i + kr;
#pragma unroll
        for (int e = 0; e < 4; ++e) scr[(nc + e) * 33 + kp] = pk2(R.v[2 * i][e] * g0, R.v[2 * i + 1][e] * g1);
    }
    asm volatile("s_waitcnt lgkmcnt(0)" ::: "memory");
    const int cch = lane & 7;
#pragma unroll
    for (int j = 0; j < 8; ++j) { const int n = (lane >> 3) + 8 * j; const LAS unsigned* s = scr + n * 33 + 4 * cch;
        u32x4 o; o.x = s[0]; o.y = s[1]; o.z = s[2]; o.w = s[3];
        if constexpr (NT) __builtin_nontemporal_store(o, (u32x4*)(WT + (size_t)(row_off + n0 + n) * K + k0 + 8 * cch)); else *(u32x4*)(WT + (size_t)(row_off + n0 + n) * K + k0 + 8 * cch) = o; }
    asm volatile("s_waitcnt lgkmcnt(0)" ::: "memory");
}
__device__ __forceinline__ void p0_transpose_item(const float* __restrict__ W, int ldw, int K, int nblk, const float* __restrict__ g, bf16_t* __restrict__ WT, int row_off, int remap, LAS unsigned* scr, int item, int lane) {
    TrRegs R; p0_tr_load(R, W, ldw, nblk, remap, item, lane); p0_tr_store(R, K, nblk, g, WT, row_off, scr, item, lane);
}
struct RowRegs { f32x4 v[8]; };
__device__ __forceinline__ void p0_row_load(RowRegs& R, int row, int lane, const float* __restrict__ x, const float* __restrict__ mem) {
    const float* src = row < M ? x + (size_t)row * DM : mem + (size_t)(row - M) * DM;
#pragma unroll
    for (int j = 0; j < 8; ++j) R.v[j] = __builtin_nontemporal_load((const f32x4*)(src + 256 * j + 4 * lane));
}
__device__ __forceinline__ void p0_row_proc(const RowRegs& R, int row, int lane, const float* __restrict__ b_f, bf16_t* __restrict__ hb, float* __restrict__ lf, float* __restrict__ rv, const LAS float* wfs) {
    const bool is_x = row < M;
    float ss = 0.f;
#pragma unroll
    for (int j = 0; j < 8; ++j) ss += R.v[j].x * R.v[j].x + R.v[j].y * R.v[j].y + R.v[j].z * R.v[j].z + R.v[j].w * R.v[j].w;
    ss = wave_sum(ss);
    const float r = rsqrtf(ss * (1.f / DM) + EPS);
    if (is_x && lane == 0) rv[row] = sqrtf(ss * (1.f / DM) + EPS);
    bf16_t* dst = hb + (size_t)row * DM;
#pragma unroll
    for (int j = 0; j < 8; ++j) { u32x2 w; w.x = pk2(R.v[j].x * r, R.v[j].y * r); w.y = pk2(R.v[j].z * r, R.v[j].w * r); *(u32x2*)(dst + 256 * j + 4 * lane) = w; }
    if (is_x) {
        float a[8] = {0.f, 0.f, 0.f, 0.f, 0.f, 0.f, 0.f, 0.f};
#pragma unroll
        for (int j = 0; j < 8; ++j)
#pragma unroll
            for (int e = 0; e < 4; ++e) {
                const float xv = R.v[j][e];
                const f32x4 w0 = *(const LAS f32x4*)(wfs + ((((j * 4 + e) * 2 + 0) * 64 + lane) * 4));
                const f32x4 w1 = *(const LAS f32x4*)(wfs + ((((j * 4 + e) * 2 + 1) * 64 + lane) * 4));
                a[0] += xv * w0.x; a[1] += xv * w0.y; a[2] += xv * w0.z; a[3] += xv * w0.w;
                a[4] += xv * w1.x; a[5] += xv * w1.y; a[6] += xv * w1.z; a[7] += xv * w1.w;
            }
#pragma unroll
        for (int cc = 0; cc < 8; ++cc) a[cc] = wave_sum(a[cc]);
        if (lane < 8) {
            float z = 0.f;
#pragma unroll
            for (int cc = 0; cc < 8; ++cc) z = (lane == cc) ? a[cc] : z;
            z = z * r + b_f[lane];
            const float ls = (z >= 0.f) ? -log1pf(expf(-z)) : z - log1pf(expf(z));
            lf[(size_t)row * 8 + lane] = ls;
        }
    }
}

struct Args { const float* in[19]; float* out; unsigned char* ws; int ph_lo, ph_hi; };
constexpr int NPH = 8;
__global__ void __launch_bounds__(NWAVES * 64, 2) mega(Args a) {
    extern __shared__ __attribute__((aligned(16))) unsigned char lds_raw[];
    PG8_LAS unsigned char* lds = (PG8_LAS unsigned char*)lds_raw;
    unsigned char* ws = a.ws;
    const int G = gridDim.x, c = blockIdx.x;
#define FRESH_TID() int tid = threadIdx.x; asm volatile("" : "+v"(tid)); const int lane = tid & 63; const int wave = __builtin_amdgcn_readfirstlane(tid >> 6); (void)lane; (void)wave;
    bf16_t* hb = (bf16_t*)(ws + WS_HB); bf16_t* proj = (bf16_t*)(ws + WS_PROJ); unsigned char* gates = ws + WS_GATES; bf16_t* kv = (bf16_t*)(ws + WS_KV); bf16_t* vmT = (bf16_t*)(ws + WS_VMT); bf16_t* PM = (bf16_t*)(ws + WS_PM);
    float* lf = (float*)(ws + WS_LF); float* nck = (float*)(ws + WS_NCK);
    float* ssp = (float*)(ws + WS_SSP); bf16_t* merged = (bf16_t*)(ws + WS_MERGED); bf16_t* U = (bf16_t*)(ws + WS_U); bf16_t* x1b = (bf16_t*)(ws + WS_X1B);
    volatile LAS unsigned* MISC = (volatile LAS unsigned*)(lds + MISC_OFF);
    if (threadIdx.x < 32) MISC[threadIdx.x] = 0u;
    __syncthreads();
    const bool multi = (a.ph_hi - a.ph_lo) > 1;
    XcdBarrier bar; bar.bar = (unsigned*)(ws + WS_CTL); bar.x = 0; bar.st = nullptr;
    if (multi) bar = xcd_barrier_post((unsigned*)(ws + WS_CTL), MISC + 8);
#define IN(k) (a.ph_lo <= (k) && (k) < a.ph_hi)
#define SEAM(k) do { if (IN(k) && IN((k) + 1)) { if ((k) >= 4 && canon) xcd_local_barrier(bar, (k) - 4); else xcd_barrier(bar); } } while (0)
    bool canon = false;
    if (IN(0)) {
        FRESH_TID();
        const float* x = a.in[0]; const float* mem = a.in[1]; const float* g1 = a.in[2]; const float* w_in = a.in[3]; const float* b_f = a.in[4];
        __syncthreads();
        LAS float* wfs = (LAS float*)lds;
        const int gw = c * NWAVES + wave, ngw = G * NWAVES;
        const int RPB = (M + BATCH * MT + G - 1) / G, row_end = (c + 1) * RPB < M + BATCH * MT ? (c + 1) * RPB : M + BATCH * MT;
        (void)gw; (void)ngw;
        RowRegs cur; int row = c * RPB + wave;
        if (row < row_end) p0_row_load(cur, row, lane, x, mem);
        { f32x4 wa[4], wb[4]; float gg[4];
#pragma unroll
          for (int e = 0; e < 4; ++e) { const int k = 4 * tid + e; const float* p = w_in + (size_t)k * IN_COLS + OC_FL; wa[e] = *(const f32x4*)p; wb[e] = *(const f32x4*)(p + 4); gg[e] = g1[k]; }
          const int j = tid >> 6, l = tid & 63;
#pragma unroll
          for (int e = 0; e < 4; ++e) { *(LAS f32x4*)(wfs + ((((j * 4 + e) * 2 + 0) * 64 + l) * 4)) = wa[e] * gg[e]; *(LAS f32x4*)(wfs + ((((j * 4 + e) * 2 + 1) * 64 + l) * 4)) = wb[e] * gg[e]; } }
        __syncthreads();
        while (row < row_end) {
            RowRegs nxt; const int nrow = row + NWAVES;
            if (nrow < row_end) p0_row_load(nxt, nrow, lane, x, mem);
            p0_row_proc(cur, row, lane, b_f, hb, lf, (float*)(ws + WS_RV), wfs);
            cur = nxt; row = nrow;
        }
        LAS unsigned* scr = (LAS unsigned*)(lds + (wave < 7 ? 65536 + wave * 8448 : 132096));
        bf16_t* WinT = (bf16_t*)(ws + WS_WIN);
        constexpr int I_IN = (DM / 64) * (NPACK / 64), I_KV = (DM / 64) * (2048 / 64);
        constexpr int NITEMS = I_IN + I_KV;
        {
            const int IPB = (NITEMS + G - 1) / G, it_end = (c + 1) * IPB < NITEMS ? (c + 1) * IPB : NITEMS;
            TrRegs cur_t; int it = c * IPB + ((wave + 6) & 7);
            if (it < it_end) { if (it < I_IN) p0_tr_load(cur_t, w_in, IN_COLS, NPACK / 64, 1, it, lane); else p0_tr_load(cur_t, a.in[9], 2048, 2048 / 64, 0, it - I_IN, lane); }
            while (it < it_end) {
                TrRegs nxt_t; const int nit = it + NWAVES;
                if (nit < it_end) { if (nit < I_IN) p0_tr_load(nxt_t, w_in, IN_COLS, NPACK / 64, 1, nit, lane); else p0_tr_load(nxt_t, a.in[9], 2048, 2048 / 64, 0, nit - I_IN, lane); }
                if (it < I_IN) p0_tr_store(cur_t, DM, NPACK / 64, g1, WinT, 0, scr, it, lane); else p0_tr_store(cur_t, DM, 2048 / 64, a.in[8], WinT, NPACK, scr, it - I_IN, lane);
                cur_t = nxt_t; it = nit;
            }
        }
    }
    SEAM(0);
    if (multi) { if (threadIdx.x == 0) MISC[12] = (G == 256 && xb_ld(&bar.bar[XB_NONCANON]) == 0u) ? 1u : 0u; __syncthreads(); canon = MISC[12] != 0u; }
    if (IN(1)) { unsigned* dq = (unsigned*)(ws + WS_CTL) + 4100;
        if (c < BATCH * FH) { FRESH_TID(); __syncthreads(); elem_scan(c, tid, lf, nck, (LAS float*)(lds + pg8::XCH_OFF)); __syncthreads(); }
        pg8::SchedP1 S{(unsigned)WS_HB, (unsigned)WS_WIN, G, c, dq + 9, (unsigned)__builtin_amdgcn_readfirstlane((int)(3648u + 16u * bar.x)), (unsigned)__builtin_amdgcn_readfirstlane((int)MISC[8])}; pg8::EpiP1 E{proj, gates, kv, vmT, a.in[6], a.in[7], a.in[10], a.in[11], a.in[5]};
        pg8::gemm_phase<pg8::EpiP1, pg8::SchedP1, true, true, true>(ws, lds, DM, DM, DM, S, E);
        {
            __syncthreads();
            volatile LAS unsigned* mb = (volatile LAS unsigned*)(lds + MISC_OFF + 80);
            if (threadIdx.x == 0) *mb = atomicAdd(dq + (c & 7), 1u);
            __syncthreads();
            const int k = __builtin_amdgcn_readfirstlane((int)*mb);
            pg8::Unit u7;
            if (k < pg8::P1_NDEAL && S.pool(3 * (G - pg8::P1_NTRI) + (pg8::P1_STATIC - 3) * G + 8 * k + (c & 7), u7)) { pg8::SchedOne S7{u7}; pg8::gemm_phase<pg8::EpiP1, pg8::SchedOne>(ws, lds, DM, DM, DM, S7, E); }
        }
    }
    if (IN(1) && IN(3)) {
        __syncthreads();
        if (threadIdx.x == 0) { unsigned* rdy = (unsigned*)(ws + WS_CTL) + 4109; XB_SPIN(xb_ld(rdy) < (unsigned)G, bar.bar); __builtin_amdgcn_fence(__ATOMIC_ACQUIRE, "agent"); asm volatile("s_waitcnt vmcnt(0)" ::: "memory"); }
        __syncthreads();
    }
    if (IN(3)) {
        constexpr int I_C3 = 3 * (1024 / 64) * (DM / 64), I_O = (DM / 64) * (DM / 64), I_UP = (DM / 64) * (DFF / 64), I_DN = (DFF / 64) * (DM / 64), I_ALL = I_C3 + I_O + I_UP + I_DN;
        static_assert(I_C3 % 16 == 0 && I_O % 16 == 0 && I_UP % 16 == 0 && I_DN % 16 == 0, "chunks do not straddle weights");
        constexpr int Q_FOX = 256, Q_MEM = Q_FOX + 128, Q_END = Q_MEM + I_ALL / 16;
        unsigned* qctr = (unsigned*)(ws + WS_CTL) + 4096;
        if (c < 30) {
            const int pmf = c + 1 + (c >= 15 ? 1 : 0), t = threadIdx.x, r = t >> 8, ch = (t & 255) * 4, row = pmf * 256 + r;
            const bf16_t* up = proj + (size_t)row * PJ + PC_V + ch; const float* cw = a.in[5];
            const u32x2 U0 = *(const u32x2*)up, U1 = *(const u32x2*)(up - PJ), U2 = *(const u32x2*)(up - 2 * PJ), Bq = *(const u32x2*)((const bf16_t*)(ws + WS_BGE) + (size_t)(pmf * 2 + r) * CW + ch);
            const f32x4 k0 = *(const f32x4*)(cw + ch), k1 = *(const f32x4*)(cw + CW + ch), k2 = *(const f32x4*)(cw + 2 * CW + ch);
            float y[4];
#pragma unroll
            for (int e = 0; e < 4; ++e) {
                const float u0 = __uint_as_float((e & 1) ? (U0[e >> 1] & 0xffff0000u) : (U0[e >> 1] << 16)), u1 = __uint_as_float((e & 1) ? (U1[e >> 1] & 0xffff0000u) : (U1[e >> 1] << 16)),
                            u2 = __uint_as_float((e & 1) ? (U2[e >> 1] & 0xffff0000u) : (U2[e >> 1] << 16)), bg = __uint_as_float((e & 1) ? (Bq[e >> 1] & 0xffff0000u) : (Bq[e >> 1] << 16));
                y[e] = bg * (k2[e] * u0 + k1[e] * u1 + k0[e] * u2); }
            u32x2 w; w.x = pg8::cvt_pk_bf16(y[0], y[1]); w.y = pg8::cvt_pk_bf16(y[2], y[3]);
            *(u32x2*)(proj + (size_t)row * PJ + PC_BG + ch) = w;
        }
#pragma unroll 1
        for (;;) {
            __syncthreads();
            int moff = MISC_OFF + 64; asm volatile("" : "+s"(moff));
            volatile LAS unsigned* mbox = (volatile LAS unsigned*)(lds + moff);
            if (threadIdx.x == 0) *mbox = atomicAdd(qctr, 1u);
            __syncthreads();
            const int it = __builtin_amdgcn_readfirstlane((int)*mbox);
            if (it >= Q_END) break;
            if (it < Q_FOX) fox::phase_item((FLAS char*)lds, proj, nck, a.in[6], a.in[7], it & 15, 15 - (it >> 4));
            else if (it < Q_MEM) { const int f = it - Q_FOX, b = f >> 6, hm = (f >> 4) & 3, qb = f & 15;
                { pg8::Unit u; u.pm = b * 16 + qb; u.pn = 0; u.seg = hm;
                  u.A = (unsigned)WS_PROJ + ((unsigned)u.pm * 256 * PJ + PC_MQ + hm * MD) * 2; u.B = (unsigned)WS_KV + ((unsigned)b * MT * 2048 + hm * MD) * 2;
                  pg8::SchedOne S{u}; pg8::EpiMemS E{PM}; pg8::gemm_phase(ws, lds, PJ, 2048, MD, S, E); }
                { pg8::Unit u; u.pm = b * 16 + qb; u.pn = 0; u.seg = hm;
                  u.A = (unsigned)WS_PM + ((unsigned)u.pm * 256 * 1024 + hm * MT) * 2; u.B = (unsigned)WS_VMT + (unsigned)(b * MH + hm) * MD * MT * 2;
                  pg8::SchedOne S{u}; pg8::EpiPlain E{proj + PC_MQ + hm * MD, PJ}; pg8::gemm_phase(ws, lds, 1024, MT, MT, S, E); } }
            else { FRESH_TID();
                LAS unsigned* scr = (LAS unsigned*)(lds + wave * 8448);
                const int r = (it - Q_MEM) * 16 + wave * 2;
                int src, ldw, K, nb, g, ci; size_t dst;
                if (r < I_C3) { const int s_ = r / (I_C3 / 3); src = 12 + s_; ldw = DM; K = 1024; nb = DM / 64; g = 0; dst = WS_WC + (size_t)s_ * DM * 1024 * 2; ci = r - s_ * (I_C3 / 3); }
                else if (r < I_C3 + I_O) { src = 15; ldw = DM; K = DM; nb = DM / 64; g = 0; dst = WS_WOUT; ci = r - I_C3; }
                else if (r < I_C3 + I_O + I_UP) { src = 17; ldw = DFF; K = DM; nb = DFF / 64; g = 1; dst = WS_WUP; ci = r - I_C3 - I_O; }
                else { src = 18; ldw = DM; K = DFF; nb = DM / 64; g = 0; dst = WS_WDN; ci = r - I_C3 - I_O - I_UP; }
                TrRegs ta, tb; p0_tr_load(ta, a.in[src], ldw, nb, 0, ci, lane); p0_tr_load(tb, a.in[src], ldw, nb, 0, ci + 1, lane);
                if (it - Q_MEM >= I_ALL / 16 - 256) { p0_tr_store<true>(ta, K, nb, g ? a.in[16] : nullptr, (bf16_t*)(ws + dst), 0, scr, ci, lane); p0_tr_store<true>(tb, K, nb, g ? a.in[16] : nullptr, (bf16_t*)(ws + dst), 0, scr, ci + 1, lane); }
                else { p0_tr_store(ta, K, nb, g ? a.in[16] : nullptr, (bf16_t*)(ws + dst), 0, scr, ci, lane); p0_tr_store(tb, K, nb, g ? a.in[16] : nullptr, (bf16_t*)(ws + dst), 0, scr, ci + 1, lane); } }
        }
    }
    SEAM(3);
    if (IN(4)) { pg8::SchedG S{(unsigned)(WS_PROJ + PC_BG * 2), (unsigned)WS_WC, PJ, 1024, M / 256, DM / 256, G, c}; pg8::EpiMerge E{gates, merged};
        pg8::gemm_phase<pg8::EpiMerge, pg8::SchedG, true, true, false, 3>(ws, lds, PJ, 1024, 1024, S, E, (unsigned)((PC_FQ - PC_BG) * 2), (unsigned)(DM * 1024 * 2)); }
    SEAM(4);
    if (IN(5)) { pg8::SchedG S{(unsigned)WS_MERGED, (unsigned)WS_WOUT, DM, DM, M / 256, DM / 256, G, c}; pg8::EpiP4 E{(const float*)(ws + WS_RV), x1b, ssp}; pg8::gemm_phase(ws, lds, DM, DM, DM, S, E); }
    SEAM(5);
    if (IN(6) && canon) { if (threadIdx.x == 0) XB_SPIN(xb_ld(&bar.bar[XB_P4DONE]) < (unsigned)G, bar.bar); __syncthreads(); }
    if (IN(6)) { pg8::SchedG S{(unsigned)WS_X1B, (unsigned)WS_WUP, DM, DM, M / 256, DFF / 256, G, c}; pg8::EpiP5 E{ssp, U};
        { pg8::Unit u0; __syncthreads(); if (S.next(0, u0)) pg8::p5_rtable(ssp, u0.pm, lds); __syncthreads(); }
        pg8::gemm_phase<pg8::EpiP5, pg8::SchedG, true, true, true>(ws, lds, DM, DM, DM, S, E); }
    SEAM(6);
    if (IN(7)) { pg8::SchedG S{(unsigned)WS_U, (unsigned)WS_WDN, DFF, DFF, M / 256, DM / 256, G, c}; pg8::EpiP6 E{a.out, x1b}; pg8::gemm_phase(ws, lds, DFF, DFF, DFF, S, E); }
#undef IN
#undef SEAM
}

#ifndef N_LAUNCHES
#define N_LAUNCHES 1
#endif
extern "C" void kernel_launch(void* const* d_in, const int* in_sizes, int n_in, void* d_out, int out_size, void* d_ws, size_t ws_size, hipStream_t stream) {
    if (n_in != 19 || in_sizes[0] != M * DM || out_size != M * DM || ws_size < WS_END) {
        fprintf(stderr, "kernel_launch: unexpected shapes (n_in %d, in0 %d, out %d, ws %zu < %zu)\n", n_in, n_in > 0 ? in_sizes[0] : -1, out_size, ws_size, (size_t)WS_END); return; }
    static bool attr = false; static int grid = 256;
    if (!attr) { attr = true;
        if (hipFuncSetAttribute((const void*)mega, hipFuncAttributeMaxDynamicSharedMemorySize, LDS_BYTES) != hipSuccess) fprintf(stderr, "kernel_launch: hipFuncSetAttribute(mega) failed\n");
        int dev = 0, cus = 0; if (hipGetDevice(&dev) == hipSuccess && hipDeviceGetAttribute(&cus, hipDeviceAttributeMultiprocessorCount, dev) == hipSuccess && cus > 0) grid = cus; }
    if (grid != 256) { fprintf(stderr, "kernel_launch: the projection phase's unit map is laid out for 256 workgroups (one per CU), device reports %d CUs\n", grid); return; }
    Args ka{}; for (int i = 0; i < 19; ++i) ka.in[i] = (const float*)d_in[i]; ka.out = (float*)d_out; ka.ws = (unsigned char*)d_ws;
    if (N_LAUNCHES == 1) {
        (void)hipMemsetAsync((char*)d_ws + WS_CTL, 0, 65536, stream);
        ka.ph_lo = 0; ka.ph_hi = NPH; hipLaunchKernelGGL(mega, dim3(grid), dim3(NWAVES * 64), LDS_BYTES, stream, ka);
    } else {
        for (int p = 0; p < NPH; ++p) { ka.ph_lo = p; ka.ph_hi = p + 1; hipLaunchKernelGGL(mega, dim3(grid), dim3(NWAVES * 64), LDS_BYTES, stream, ka); }
    }
}
```
